# Optimizing an MI355X kernel written in HIP

```python
import jax, jax.numpy as jnp
from jax import lax
import numpy as np

D_MODEL = 1024
BATCH = 4
SEQ = 4096
DEPTH = 1
DEC_BATCH = 32
DEC_SEQ = 4
PAST_LEN = 8192
PAGE_SIZE = 128

HEAD_DIM = 64
N_HEADS_A = 8
N_KV_A = 2
GROUP_A = N_HEADS_A // N_KV_A
N_IDX_HEADS = 8
IDX_DIM = 64
TOPK_MAX = 256
N_HEADS_B = 8
Q_A_W = N_HEADS_A * HEAD_DIM
KV_A_W = 2 * N_KV_A * HEAD_DIM
Q_I_W = N_IDX_HEADS * IDX_DIM
Q_B_W = N_HEADS_B * HEAD_DIM
KV_B_W = 2 * N_HEADS_B * HEAD_DIM
IN_W = Q_A_W + KV_A_W + Q_I_W + IDX_DIM + N_IDX_HEADS + Q_B_W + KV_B_W + 2 * D_MODEL
D_FF = -(-8 * D_MODEL // (3 * 256)) * 256
ROPE_THETA = 10000.0
QBLK = 128
RMS_EPS = 1e-6

kernel_name = 'dsa_stickbreak_gated_hybrid_step'


def _rmsnorm(x, g):
    x32 = x.astype(jnp.float32)
    y = x32 * lax.rsqrt(jnp.mean(x32 * x32, axis=-1, keepdims=True) + RMS_EPS)
    return (y * g.astype(jnp.float32)).astype(x.dtype)


def _rope(x, pos):
    half = x.shape[-1] // 2
    inv_freq = ROPE_THETA ** (-jnp.arange(half, dtype=jnp.float32) / half)
    ang = pos.astype(jnp.float32)[:, None] * inv_freq[None, :]
    cos = jnp.cos(ang)[:, None, :]
    sin = jnp.sin(ang)[:, None, :]
    x1 = x[..., :half].astype(jnp.float32)
    x2 = x[..., half:].astype(jnp.float32)
    return jnp.concatenate([x1 * cos - x2 * sin, x2 * cos + x1 * sin], axis=-1).astype(x.dtype)


def _project(xn, w_in, pos):
    b, t, _ = xn.shape
    y = xn @ w_in
    sizes = (Q_A_W, KV_A_W, Q_I_W, IDX_DIM, N_IDX_HEADS, Q_B_W, KV_B_W)
    offs = []
    acc = 0
    for s in sizes:
        acc += s
        offs.append(acc)
    p = jnp.split(y, offs, axis=-1)
    q_a = _rope(p[0].reshape(b, t, N_HEADS_A, HEAD_DIM), pos)
    kv = p[1].reshape(b, t, 2, N_KV_A, HEAD_DIM)
    kv_a = jnp.stack([_rope(kv[:, :, 0], pos), kv[:, :, 1]], axis=2)
    q_i = _rope(p[2].reshape(b, t, N_IDX_HEADS, IDX_DIM), pos)
    k_i = _rope(p[3].reshape(b, t, 1, IDX_DIM), pos)[:, :, 0]
    w_i = p[4] * (N_IDX_HEADS ** -0.5)
    q_b = p[5].reshape(b, t, N_HEADS_B, HEAD_DIM)
    kv_b = p[6].reshape(b, t, 2, N_HEADS_B, HEAD_DIM)
    gates = jax.nn.sigmoid(p[7].astype(jnp.float32)).astype(xn.dtype).reshape(b, t, 2, D_MODEL)
    return q_a, kv_a, q_i, k_i, w_i, q_b, kv_b, gates


def _dsa_block(qpos, q_a, q_i, w_i, kv_a, k_i):
    b, tb = q_a.shape[:2]
    n_keys = k_i.shape[1]
    n_sel = max(1, min(TOPK_MAX, n_keys // 4))
    rel = jax.nn.relu(jnp.einsum('bthe,bse->bths', q_i, k_i).astype(jnp.float32))
    score = jnp.einsum('bth,bths->bts', w_i.astype(jnp.float32), rel) * (IDX_DIM ** -0.5)
    kpos = jnp.arange(n_keys, dtype=jnp.int32)
    causal = kpos[None, :] <= qpos[:, None]
    score = jnp.where(causal[None], score, -jnp.inf)
    _, idx = lax.top_k(score, n_sel)
    valid = idx <= qpos[None, :, None]
    sel = jax.vmap(lambda rows, ii: rows[ii])(kv_a, idx)
    qg = q_a.reshape(b, tb, N_KV_A, GROUP_A, HEAD_DIM)
    s = jnp.einsum('btcgd,btncd->btcgn', qg, sel[:, :, :, 0]).astype(jnp.float32) * (HEAD_DIM ** -0.5)
    s = jnp.where(valid[:, :, None, None, :], s, -jnp.inf)
    p = jax.nn.softmax(s, axis=-1).astype(q_a.dtype)
    o = jnp.einsum('btcgn,btncd->btcgd', p, sel[:, :, :, 1])
    return o.reshape(b, tb, Q_A_W)


def _sb_block(qpos, q_b, kv_b):
    b, tb = q_b.shape[:2]
    n_keys = kv_b.shape[1]
    z = jnp.einsum('bthd,bshd->bhts', q_b, kv_b[:, :, 0]).astype(jnp.float32) * (HEAD_DIM ** -0.5)
    kpos = jnp.arange(n_keys, dtype=jnp.int32)
    strict = (kpos[None, :] < qpos[:, None])[None, None]
    log_beta = jax.nn.log_sigmoid(z)
    log_rest = jnp.where(strict, log_beta - z, 0.0)
    later = lax.cumsum(log_rest, axis=3, reverse=True) - log_rest
    a = jnp.where(strict, jnp.exp(log_beta + later), 0.0)
    o = jnp.einsum('bhts,bshd->bthd', a.astype(q_b.dtype), kv_b[:, :, 1])
    return o.reshape(b, tb, Q_B_W)


def _sweep(fn, pos, *qs):
    t = pos.shape[0]
    if t % QBLK != 0 or t <= QBLK:
        return fn(pos, *qs)
    nb = t // QBLK

    def split(a):
        return jnp.moveaxis(a.reshape(a.shape[0], nb, QBLK, *a.shape[2:]), 1, 0)

    out = lax.map(lambda args: fn(*args), (pos.reshape(nb, QBLK),) + tuple(split(a) for a in qs))
    out = jnp.moveaxis(out, 0, 1)
    return out.reshape(out.shape[0], t, *out.shape[3:])


def _mixers(pos, q_a, kv_a_ctx, q_i, k_i_ctx, w_i, q_b, kv_b_ctx, gates, w_br_a, w_br_b, w_o):
    o_a = _sweep(lambda qp, qa, qi, wi: _dsa_block(qp, qa, qi, wi, kv_a_ctx, k_i_ctx), pos, q_a, q_i, w_i)
    o_b = _sweep(lambda qp, qb: _sb_block(qp, qb, kv_b_ctx), pos, q_b)
    merged = gates[:, :, 0] * (o_a @ w_br_a) + gates[:, :, 1] * (o_b @ w_br_b)
    return merged @ w_o


def _ffn(h, w_gate, w_up, w_down):
    return (jax.nn.silu(h @ w_gate) * (h @ w_up)) @ w_down


def _gather_pages(pool, page_table):
    rows = pool[page_table]
    b, n_pages, page = rows.shape[:3]
    return rows.reshape(b, n_pages * page, *rows.shape[3:])


def setup_inputs(seed: int = 0) -> dict:
    key = jax.random.key(seed)
    ks = jax.random.split(key, 20)
    f32 = jnp.float32
    n_pages = PAST_LEN // PAGE_SIZE
    n_used = DEC_BATCH * n_pages
    n_pool = n_used + max(1, n_used // 4)

    def nrm(k, shape, scale=1.0):
        return jax.random.normal(k, shape, f32) * scale

    page_table = jax.random.permutation(ks[5], n_pool)[:n_used].reshape(DEC_BATCH, n_pages).astype(jnp.int32)
    return {
        'x_prompt': nrm(ks[0], (BATCH, SEQ, D_MODEL)),
        'x_sample': nrm(ks[1], (DEC_BATCH, DEC_SEQ, D_MODEL)),
        'cache_kv_a': nrm(ks[2], (DEPTH, n_pool, PAGE_SIZE, 2, N_KV_A, HEAD_DIM)),
        'cache_k_idx': nrm(ks[3], (DEPTH, n_pool, PAGE_SIZE, IDX_DIM)),
        'cache_kv_b': nrm(ks[4], (DEPTH, n_pool, PAGE_SIZE, 2, N_HEADS_B, HEAD_DIM)),
        'page_table': page_table,
        'w_in': nrm(ks[6], (DEPTH, D_MODEL, IN_W), D_MODEL ** -0.5),
        'w_br_a': nrm(ks[7], (DEPTH, Q_A_W, D_MODEL), Q_A_W ** -0.5),
        'w_br_b': nrm(ks[8], (DEPTH, Q_B_W, D_MODEL), Q_B_W ** -0.5),
        'w_o': nrm(ks[9], (DEPTH, D_MODEL, D_MODEL), D_MODEL ** -0.5),
        'norm_attn': 1.0 + nrm(ks[10], (DEPTH, D_MODEL), 0.01),
        'norm_ffn': 1.0 + nrm(ks[11], (DEPTH, D_MODEL), 0.01),
        'w_ffn_gate': nrm(ks[12], (DEPTH, D_MODEL, D_FF), D_MODEL ** -0.5),
        'w_ffn_up': nrm(ks[13], (DEPTH, D_MODEL, D_FF), D_MODEL ** -0.5),
        'w_ffn_down': nrm(ks[14], (DEPTH, D_FF, D_MODEL), D_FF ** -0.5),
        'norm_final': 1.0 + nrm(ks[15], (D_MODEL,), 0.01),
    }


def reference(x_prompt, x_sample, cache_kv_a, cache_k_idx, cache_kv_b, page_table, w_in, w_br_a, w_br_b,
              w_o, norm_attn, norm_ffn, w_ffn_gate, w_ffn_up, w_ffn_down, norm_final):
    pos_p = jnp.arange(x_prompt.shape[1], dtype=jnp.int32)
    past_len = page_table.shape[1] * cache_kv_a.shape[2]
    pos_s = past_len + jnp.arange(x_sample.shape[1], dtype=jnp.int32)
    hp, hs = x_prompt, x_sample
    kv_a_p, k_i_p, kv_b_p, kv_a_s, k_i_s, kv_b_s = [], [], [], [], [], []
    for layer in range(DEPTH):
        xn = _rmsnorm(hp, norm_attn[layer])
        q_a, kv_a, q_i, k_i, w_i, q_b, kv_b, gates = _project(xn, w_in[layer], pos_p)
        hp = hp + _mixers(pos_p, q_a, kv_a, q_i, k_i, w_i, q_b, kv_b, gates,
                          w_br_a[layer], w_br_b[layer], w_o[layer])
        hp = hp + _ffn(_rmsnorm(hp, norm_ffn[layer]), w_ffn_gate[layer], w_ffn_up[layer], w_ffn_down[layer])
        kv_a_p.append(kv_a)
        k_i_p.append(k_i)
        kv_b_p.append(kv_b)

        xn = _rmsnorm(hs, norm_attn[layer])
        q_a, kv_a, q_i, k_i, w_i, q_b, kv_b, gates = _project(xn, w_in[layer], pos_s)
        kv_a_ctx = jnp.concatenate([_gather_pages(cache_kv_a[layer], page_table), kv_a], axis=1)
        k_i_ctx = jnp.concatenate([_gather_pages(cache_k_idx[layer], page_table), k_i], axis=1)
        kv_b_ctx = jnp.concatenate([_gather_pages(cache_kv_b[layer], page_table), kv_b], axis=1)
        hs = hs + _mixers(pos_s, q_a, kv_a_ctx, q_i, k_i_ctx, w_i, q_b, kv_b_ctx, gates,
                          w_br_a[layer], w_br_b[layer], w_o[layer])
        hs = hs + _ffn(_rmsnorm(hs, norm_ffn[layer]), w_ffn_gate[layer], w_ffn_up[layer], w_ffn_down[layer])
        kv_a_s.append(kv_a)
        k_i_s.append(k_i)
        kv_b_s.append(kv_b)
    y_prompt = _rmsnorm(hp, norm_final)
    y_sample = _rmsnorm(hs, norm_final)
    return (y_prompt, y_sample, jnp.stack(kv_a_p), jnp.stack(k_i_p), jnp.stack(kv_b_p),
            jnp.stack(kv_a_s), jnp.stack(k_i_s), jnp.stack(kv_b_s))
```

```cpp
#include <hip/hip_runtime.h>
#include <cstdio>
#include <cstdint>

#define LAS __attribute__((address_space(3)))
#define GAS __attribute__((address_space(1)))
typedef _Float16 f16;
typedef _Float16 half8 __attribute__((ext_vector_type(8)));
typedef _Float16 half4 __attribute__((ext_vector_type(4)));
typedef _Float16 half2v __attribute__((ext_vector_type(2)));
typedef float f32x2 __attribute__((ext_vector_type(2)));
typedef float f32x4 __attribute__((ext_vector_type(4)));
typedef float f32x16 __attribute__((ext_vector_type(16)));
typedef unsigned u32x4 __attribute__((ext_vector_type(4)));
typedef unsigned u32x2 __attribute__((ext_vector_type(2)));
typedef short s16x4 __attribute__((ext_vector_type(4)));

namespace pg8 {
constexpr int BM = 256, BK = 64, HALF = 128, HTB = HALF * BK * 2  , STAGE_BYTES = 8 * HTB, NXCD = 8, WGM = 8;

__host__ __device__ __forceinline__ int lds_byte(int r, int c) { const int st = (r >> 4) * 2 + (c >> 5), rr = r & 15, cc = c & 31, ob = rr * 64 + cc * 2; return st * 1024 + (ob ^ (((ob >> 9) & 1) << 5)); }
__host__ __device__ __forceinline__ void stage_rc(int b, int& R, int& C) { const int st = b / 1024, sb = b % 1024, swz = sb ^ (((sb >> 9) & 1) << 5); R = (st >> 1) * 16 + swz / 64; C = (st & 1) * 32 + (swz % 64) / 2; }
__host__ __device__ __forceinline__ int perm32(int rho) { const int n = rho >> 4, i = rho & 15; return 8 * (i >> 2) + 4 * n + (i & 3); }

struct Unit { int pm, pn, ka, kb, sub; };
struct Gemm { const f16* A; const f16* Bt; int lda, ldb, K; };

struct StaticOrder {
    int nM, nN, nwg, G, c;
    __host__ __device__ void init(int M, int N, int G_, int c_) { nM = M / BM; nN = N / BM; nwg = nM * nN; G = G_; c = c_; }
    __host__ __device__ bool next(int i, Unit& u) const {
        const long L = (long)i * G + c; if (L >= nwg) return false;
        int wgid = (int)L; { const int q = nwg / NXCD, r = nwg % NXCD, xcd = wgid % NXCD, off = wgid / NXCD; wgid = (xcd < r ? xcd * (q + 1) : r * (q + 1) + (xcd - r) * q) + off; }
        const int nig = WGM * nN, gid = wgid / nig, fm = gid * WGM, gsz = (nM - fm) < WGM ? (nM - fm) : WGM;
        u.pm = fm + ((wgid % nig) % gsz); u.pn = (wgid % nig) / gsz; u.ka = 0; u.kb = 0; u.sub = 1; return true;
    }
};
struct PairOrder {
    StaticOrder S; int K;
    __host__ __device__ bool next(int i, Unit& u) const { if (!S.next(i >> 1, u)) return false; u.sub = i & 1; u.ka = u.kb = (i & 1) * K; return true; }
};

template <class Epi, class Sched, bool ALIGN_EPI = false>
__device__ __forceinline__ void gemm_phase(LAS unsigned char* lds, const Gemm g, const Sched& S, const Epi& E) {
    const int tid = threadIdx.x, wid = __builtin_amdgcn_readfirstlane(tid >> 6), lane = tid & 63, wr = wid >> 2, wc = wid & 3, fr = lane & 15, fq = lane >> 4;
    const int nt = g.K / BK;
    unsigned voffA[2], voffB[2];
#pragma unroll
    for (int i = 0; i < 2; ++i) { int R, C; stage_rc(tid * 16 + i * 8192, R, C); const int Rb = (R & ~31) + perm32(R & 31);
        voffA[i] = (unsigned)(R * g.lda + C) * 2u; voffB[i] = (unsigned)(Rb * g.ldb + C) * 2u; }
    const size_t kstep = (size_t)(BK * 2);
    const size_t hstepA = (size_t)HALF * g.lda * 2, hstepB = (size_t)HALF * g.ldb * 2;
    const size_t tstepA = 2 * hstepA, tstepB = 2 * hstepB;
    const unsigned ldsw = (unsigned)wid * 1024u;
    const int aoff = lds_byte(wr * 64 + fr, fq * 8), boff = lds_byte(wc * 32 + fr, fq * 8);
#define PG8_SA(b, h) (((b) * 2 + (h)) * HTB)
#define PG8_SB(b, h) ((4 + (b) * 2 + (h)) * HTB)
#define PG8_STAGE(bufoff, gbase, voff) do { _Pragma("unroll") for (int _i = 0; _i < 2; ++_i) \
        __builtin_amdgcn_global_load_lds((const unsigned*)((const char*)(gbase) + (voff)[_i]), (LAS unsigned*)(lds + (bufoff) + ldsw + _i * 8192), 16, 0, 0); } while (0)
#define PG8_LDA(dst, b, h) do { _Pragma("unroll") for (int m = 0; m < 4; ++m) _Pragma("unroll") for (int k = 0; k < 2; ++k) dst[m][k] = *(const LAS half8*)(lds + PG8_SA(b, h) + aoff + m * 2048 + k * 1024); } while (0)
#define PG8_LDB(dst, b, h) do { _Pragma("unroll") for (int n = 0; n < 2; ++n) _Pragma("unroll") for (int k = 0; k < 2; ++k) dst[n][k] = *(const LAS half8*)(lds + PG8_SB(b, h) + boff + n * 2048 + k * 1024); } while (0)
#define PG8_MMA(ai, bj, At, Bt) do { __builtin_amdgcn_s_setprio(1); _Pragma("unroll") for (int m = 0; m < 4; ++m) _Pragma("unroll") for (int n = 0; n < 2; ++n) _Pragma("unroll") for (int k = 0; k < 2; ++k) \
        acc[ai][bj][m][n] = __builtin_amdgcn_mfma_f32_16x16x32_f16(Bt[n][k], At[m][k], acc[ai][bj][m][n], 0, 0, 0); __builtin_amdgcn_s_setprio(0); } while (0)
#define PG8_WAIT_V(n) asm volatile("s_waitcnt vmcnt(" #n ")" ::: "memory")
#define PG8_WAIT_L(n) asm volatile("s_waitcnt lgkmcnt(" #n ")" ::: "memory")
#define PG8_BAR __builtin_amdgcn_s_barrier()
#define PG8_SCHED __builtin_amdgcn_sched_barrier(0)
#define PG8_ZERO() do { _Pragma("unroll") for (int a = 0; a < 2; ++a) _Pragma("unroll") for (int b = 0; b < 2; ++b) _Pragma("unroll") for (int m = 0; m < 4; ++m) _Pragma("unroll") for (int n = 0; n < 2; ++n) acc[a][b][m][n] = (f32x4){0.f, 0.f, 0.f, 0.f}; } while (0)
    Unit cur, nxt; int ui = 0;
    if (!S.next(0, cur)) return;
    f32x4 acc[2][2][4][2];
    PG8_ZERO();
    half8 At[4][2], B0[2][2], B1[2][2];
    const char* cA = (const char*)g.A + (size_t)cur.pm * tstepA + (size_t)cur.ka * 2; const char* cB = (const char*)g.Bt + (size_t)cur.pn * tstepB + (size_t)cur.kb * 2;
    PG8_STAGE(PG8_SB(0, 0), cB, voffB); PG8_STAGE(PG8_SB(0, 1), cB + hstepB, voffB); PG8_STAGE(PG8_SA(0, 0), cA, voffA); PG8_STAGE(PG8_SA(0, 1), cA + hstepA, voffA);
    if (wr == 1) PG8_BAR;
    PG8_WAIT_V(2); PG8_BAR;
    PG8_STAGE(PG8_SB(1, 0), cB + kstep, voffB); PG8_STAGE(PG8_SA(1, 0), cA + kstep, voffA); PG8_STAGE(PG8_SB(1, 1), cB + hstepB + kstep, voffB);
    PG8_WAIT_V(6); PG8_BAR;
    for (;;) {
        const bool has_next = S.next(ui + 1, nxt);
        const char* nA = has_next ? (const char*)g.A + (size_t)nxt.pm * tstepA + (size_t)nxt.ka * 2 : cA; const char* nB = has_next ? (const char*)g.Bt + (size_t)nxt.pn * tstepB + (size_t)nxt.kb * 2 : cB;
        for (int t = 0; t < nt; t += 2) {
            const bool last = (t == nt - 2);
            const char* a1 = cA + (size_t)(t + 1) * kstep;
            const char* a2 = last ? nA : cA + (size_t)(t + 2) * kstep; const char* b2 = last ? nB : cB + (size_t)(t + 2) * kstep;
            const char* a3 = a2 + kstep; const char* b3 = b2 + kstep;
            PG8_LDB(B0, 0, 0); PG8_LDB(B1, 0, 1); PG8_SCHED; PG8_LDA(At, 0, 0); PG8_STAGE(PG8_SA(1, 1), a1 + hstepA, voffA);
            PG8_WAIT_V(8); PG8_WAIT_L(0); PG8_BAR; PG8_MMA(0, 0, At, B0); PG8_MMA(0, 1, At, B1); PG8_BAR; PG8_SCHED;
            PG8_LDA(At, 0, 1); PG8_STAGE(PG8_SB(0, 0), b2, voffB); PG8_STAGE(PG8_SB(0, 1), b2 + hstepB, voffB); PG8_STAGE(PG8_SA(0, 0), a2, voffA);
            PG8_WAIT_V(8); PG8_WAIT_L(0); PG8_BAR; PG8_MMA(1, 0, At, B0); PG8_MMA(1, 1, At, B1); PG8_BAR; PG8_SCHED;
            PG8_LDB(B0, 1, 0); PG8_LDB(B1, 1, 1); PG8_SCHED; PG8_LDA(At, 1, 0); PG8_STAGE(PG8_SA(0, 1), a2 + hstepA, voffA);
            PG8_WAIT_V(8); PG8_WAIT_L(0); PG8_BAR; PG8_MMA(0, 0, At, B0); PG8_MMA(0, 1, At, B1); PG8_BAR; PG8_SCHED;
            PG8_LDA(At, 1, 1); PG8_STAGE(PG8_SB(1, 0), b3, voffB); PG8_STAGE(PG8_SB(1, 1), b3 + hstepB, voffB); PG8_STAGE(PG8_SA(1, 0), a3, voffA);
            PG8_WAIT_V(8); PG8_WAIT_L(0); PG8_BAR; PG8_MMA(1, 0, At, B0); PG8_MMA(1, 1, At, B1); PG8_BAR; PG8_SCHED;
        }
        if constexpr (ALIGN_EPI) { if (wr == 0) PG8_BAR; }
        E(acc, cur, wr, wc, fr, fq);
        if (!has_next) break;
        if (E.zero_after(cur)) PG8_ZERO();
        cur = nxt; cA = nA; cB = nB; ++ui;
        if constexpr (ALIGN_EPI) { if (wr == 1) PG8_BAR; }
    }
    PG8_WAIT_V(0);
    if constexpr (!ALIGN_EPI) { if (wr == 0) PG8_BAR; }
    PG8_BAR;
#undef PG8_SA
#undef PG8_SB
#undef PG8_STAGE
#undef PG8_LDA
#undef PG8_LDB
#undef PG8_MMA
#undef PG8_WAIT_V
#undef PG8_WAIT_L
#undef PG8_BAR
#undef PG8_SCHED
#undef PG8_ZERO
}
}
#define MK_N_LAUNCHES 1
constexpr int DM = 1024, NB = 4, SEQ = 4096, DECB = 32, DECS = 4, PAST = 8192, PAGE = 128, NPAGES = PAST / PAGE;
constexpr int MP = NB * SEQ, MS = DECB * DECS, MR = MP + MS, MT = 16640;
constexpr int HD = 64, IN_W = 4936, NIN = 5120, DFF = 2816, NGU = 2 * DFF, TOPK = 256;
constexpr int NKS = PAST + DECS;
constexpr float RMS_EPS = 1e-6f;
constexpr int NROPE = SEQ + DECS;
constexpr size_t O_Y_P = 0, O_Y_S = O_Y_P + (size_t)MP * DM, O_KVA_P = O_Y_S + (size_t)MS * DM, O_KI_P = O_KVA_P + (size_t)MP * 256, O_KVB_P = O_KI_P + (size_t)MP * 64,
                 O_KVA_S = O_KVB_P + (size_t)MP * 1024, O_KI_S = O_KVA_S + (size_t)MS * 256, O_KVB_S = O_KI_S + (size_t)MS * 64, O_END = O_KVB_S + (size_t)MS * 1024;
static_assert(O_END == 39100416, "d_out size");

constexpr size_t MiB = 1u << 20;
constexpr size_t al(size_t x) { return (x + MiB - 1) / MiB * MiB; }
constexpr size_t WS_CTL = 0, CTL_ZERO_BYTES = 1 * MiB;
constexpr size_t WS_WIN = 2 * MiB;
constexpr size_t WS_WBR = WS_WIN + al((size_t)NIN * DM * 2);
constexpr size_t WS_WO = WS_WBR + al((size_t)DM * DM * 2);
constexpr size_t WS_WGU = WS_WO + al((size_t)DM * DM * 2);
constexpr size_t WS_WDN = WS_WGU + al((size_t)NGU * DM * 2);
constexpr size_t WS_ROPE = WS_WDN + al((size_t)DM * DFF * 2);
constexpr size_t WS_RSTD1 = WS_ROPE + al((size_t)NROPE * 32 * 8);
constexpr size_t WS_SS2 = WS_RSTD1 + al((size_t)MT * 4);
constexpr size_t WS_SS3 = WS_SS2 + al((size_t)MT * 16 * 4);
constexpr size_t WS_XH = WS_SS3 + al((size_t)MT * 16 * 4);
constexpr size_t WS_QA = WS_XH + al((size_t)MT * DM * 2);
constexpr size_t WS_KA = WS_QA + al((size_t)MT * 512 * 2);
constexpr size_t WS_VA = WS_KA + al((size_t)MT * 128 * 2);
constexpr size_t WS_QI = WS_VA + al((size_t)MT * 128 * 2);
constexpr size_t WS_KI = WS_QI + al((size_t)MT * 512 * 2);
constexpr size_t WS_WI = WS_KI + al((size_t)MT * 64 * 2);
constexpr size_t WS_QB = WS_WI + al((size_t)MT * 8 * 4);
constexpr size_t WS_KB = WS_QB + al((size_t)MT * 512 * 2);
constexpr size_t WS_VB = WS_KB + al((size_t)MT * 512 * 2);
constexpr size_t WS_G = WS_VB + al((size_t)MT * 512 * 2);
constexpr size_t WS_OAB = WS_G + al((size_t)MT * 2048 * 2);
constexpr size_t WS_MG = WS_OAB + al((size_t)MT * DM * 2);
constexpr size_t WS_H = WS_MG + al((size_t)MT * DM * 2);
constexpr size_t WS_HH = WS_H + al((size_t)MT * DM * 4);
constexpr size_t WS_ACT = WS_HH + al((size_t)MT * DM * 2);
constexpr size_t WS_END = WS_ACT + al((size_t)MT * DFF * 2);
constexpr int CW_QUEUE = 64;
constexpr int CW_BAR = 4096;

constexpr int RING_BYTES = 131072;
constexpr int LDS_BYTES = 163840;
constexpr int MISC_OFF = LDS_BYTES - 256;
constexpr int NWAVES = 8;

#define RLX_AGENT __ATOMIC_RELAXED, __HIP_MEMORY_SCOPE_AGENT
#define LDS_WAIT() asm volatile("s_waitcnt lgkmcnt(0)" ::: "memory")
#define VM_WAIT() asm volatile("s_waitcnt vmcnt(0)" ::: "memory")

#define XB_TMO      128
#define XB_XCNT(j)  (256  + 64 * (j))
#define XB_XSUB(j)  (1280 + 64 * (j))
#define XB_XGEN(j)  (2304 + 64 * (j))
#define XB_TOP      3328
#define XB_TOPGEN   3392
#define XCD_BAR_WORDS 3456
#define XB_SPIN_CAP (1u << 18)

__device__ __forceinline__ unsigned xb_ld(unsigned* p)              { return __hip_atomic_load(p, __ATOMIC_RELAXED, __HIP_MEMORY_SCOPE_AGENT); }
__device__ __forceinline__ unsigned xb_add(unsigned* p, unsigned v) { return __hip_atomic_fetch_add(p, v, __ATOMIC_RELAXED, __HIP_MEMORY_SCOPE_AGENT); }
__device__ __forceinline__ unsigned xb_xcc_id() { return (unsigned)__builtin_amdgcn_s_getreg((3 << 11) | 20) & 0xFu; }
#define XB_SPIN(cond, bar) do { unsigned _sp = 0; while (cond) { __builtin_amdgcn_s_sleep(1); \
    if ((++_sp & 255u) == 0u) { if (xb_ld(&(bar)[XB_TMO])) break; if (_sp > XB_SPIN_CAP) { atomicAdd(&(bar)[XB_TMO], 1u); break; } } } } while (0)

struct XcdBarrier { unsigned* bar; unsigned x; volatile LAS unsigned* st; };

__device__ __forceinline__ XcdBarrier xcd_barrier_post(unsigned* bar, volatile LAS unsigned* st) {
    XcdBarrier b; b.bar = bar; b.x = xb_xcc_id(); b.st = st;
    if (threadIdx.x == 0) (void)xb_add(&bar[XB_XCNT(b.x)], 1u);
    return b;
}
__device__ __forceinline__ void xcd_barrier_complete(unsigned* bar, unsigned x, unsigned& nloc, unsigned& nx) {
    const unsigned G = gridDim.x * gridDim.y * gridDim.z;
    unsigned sum, cnt, mine, sp = 0u;
    for (;;) {
        sum = 0u; cnt = 0u; mine = 0u;
#pragma unroll
        for (unsigned j = 0; j < 16; ++j) { const unsigned c = xb_ld(&bar[XB_XCNT(j)]); sum += c; cnt += (c > 0u) ? 1u : 0u; mine = (j == x) ? c : mine; }
        if (sum == G) break;
        __builtin_amdgcn_s_sleep(1);
        if ((++sp & 255u) == 0u) { if (xb_ld(&bar[XB_TMO])) break; if (sp > XB_SPIN_CAP) { atomicAdd(&bar[XB_TMO], 1u); break; } }
    }
    nloc = mine > 0u ? mine : 1u; nx = cnt > 0u ? cnt : 1u;
}
__device__ __forceinline__ void xcd_barrier(const XcdBarrier& b) {
    asm volatile("s_waitcnt vmcnt(0)" ::: "memory");
    __syncthreads();
    if (threadIdx.x == 0) {
        unsigned* bar = b.bar;
        __builtin_amdgcn_s_waitcnt(0);
        unsigned nloc = b.st[0], nx = b.st[1];
        if (nloc == 0u) { xcd_barrier_complete(bar, b.x, nloc, nx); b.st[0] = nloc; b.st[1] = nx; }
        const unsigned old = xb_add(&bar[XB_XSUB(b.x)], 1u);
        const unsigned gen = old / nloc;
        if (old + 1u == (gen + 1u) * nloc) {
            __builtin_amdgcn_fence(__ATOMIC_RELEASE, "agent");
            asm volatile("s_waitcnt vmcnt(0)" ::: "memory");
            const unsigned og = xb_add(&bar[XB_TOP], 1u);
            const unsigned tg = og / nx;
            if (og + 1u == (tg + 1u) * nx) xb_add(&bar[XB_TOPGEN], 1u);
            else XB_SPIN(xb_ld(&bar[XB_TOPGEN]) == tg, bar);
            __builtin_amdgcn_fence(__ATOMIC_ACQUIRE, "agent");
            xb_add(&bar[XB_XGEN(b.x)], 1u);
            asm volatile("s_waitcnt vmcnt(0)" ::: "memory");
        } else {
            XB_SPIN(xb_ld(&bar[XB_XGEN(b.x)]) == gen, bar);
            __builtin_amdgcn_fence(__ATOMIC_ACQUIRE, "agent");
            asm volatile("s_waitcnt vmcnt(0)" ::: "memory");
        }
    }
    __syncthreads();
}

struct Params {
    const float *x_p, *x_s, *c_kva, *c_ki, *c_kvb; const int* pt;
    const float *w_in, *w_bra, *w_brb, *w_o, *g_attn, *g_ffn, *w_gate, *w_up, *w_down, *g_final;
    float* out; unsigned char* ws;
    int ph_lo, ph_hi;
};
struct Frame {
    LAS unsigned char* lds; volatile LAS unsigned* MISC; unsigned* ctl;
    int tid, lane, wave, G, bx;
};
__device__ __forceinline__ float wave_sum(float v) {
#pragma unroll
    for (int o = 1; o < 64; o <<= 1) v += __shfl_xor(v, o);
    return v;
}
__device__ __forceinline__ unsigned pkh(float lo, float hi) { half2v h = {(f16)lo, (f16)hi}; return __builtin_bit_cast(unsigned, h); }
__device__ __forceinline__ u32x4 pk8(const float* v) { u32x4 w; w.x = pkh(v[0], v[1]); w.y = pkh(v[2], v[3]); w.z = pkh(v[4], v[5]); w.w = pkh(v[6], v[7]); return w; }
__host__ __device__ __forceinline__ int in_col(int hs, int d) { return hs < 21 ? hs * 64 + d : (hs == 21 ? 1344 + d : 1352 + (hs - 22) * 64 + d); }

__device__ __forceinline__ void tr_item(const float* __restrict__ W, int ldw, int k0, int L0, int nvalid, const float* __restrict__ scale, f16* dst, int lddst, LAS float* scr, int lane) {
#pragma unroll 8
    for (int i = 0; i < 32; ++i) { const int kk = 2 * i + (lane >> 5), c = lane & 31; float v = 0.f;
        if (c < nvalid) { v = W[(size_t)(k0 + kk) * ldw + L0 + c]; if (scale) v *= scale[k0 + kk]; }
        scr[kk * 33 + c] = v; }
    LDS_WAIT(); asm volatile("" ::: "memory");
    const int c8 = lane & 7;
#pragma unroll
    for (int j = 0; j < 4; ++j) { const int n = (lane >> 3) + 8 * j; const LAS float* s = scr + (8 * c8) * 33 + n;
        u32x4 o; o.x = pkh(s[0 * 33], s[1 * 33]); o.y = pkh(s[2 * 33], s[3 * 33]); o.z = pkh(s[4 * 33], s[5 * 33]); o.w = pkh(s[6 * 33], s[7 * 33]);
        *(u32x4*)(dst + (size_t)n * lddst + 8 * c8) = o; }
    LDS_WAIT(); asm volatile("" ::: "memory");
}

__device__ __forceinline__ void p0_prologue(const Frame& F, const Params& P) {
    unsigned char* ws = P.ws;
    LAS float* scr = (LAS float*)(F.lds + F.wave * 16384);
    const int gw = F.bx * NWAVES + F.wave, NGW = F.G * NWAVES;
    constexpr int I_IN = 16 * (NIN / 32), I_BR = 8 * 32, I_O = 16 * 32, I_GU = 16 * (NGU / 32), I_DN = (DFF / 64) * 32;
    constexpr int NITEMS = I_IN + 2 * I_BR + I_O + I_GU + I_DN;
    for (int it = gw; it < NITEMS; it += NGW) {
        int r = it;
        if (r < I_IN) { const int nb = r % (NIN / 32), kb = r / (NIN / 32), n0 = 32 * nb, pn = n0 >> 8, bj = (n0 >> 7) & 1, wc = (n0 >> 5) & 3, hs = 4 * pn + wc;
            const int nvalid = hs == 21 ? (bj == 0 ? 8 : 0) : (hs < 78 ? 32 : 0);
            tr_item(P.w_in, IN_W, 64 * kb, in_col(hs < 78 ? hs : 0, 32 * bj), nvalid, P.g_attn, (f16*)(ws + WS_WIN) + (size_t)n0 * DM + 64 * kb, DM, scr, F.lane); continue; }
        r -= I_IN;
        if (r < I_BR) { const int nb = r % 32, kb = r / 32; tr_item(P.w_bra, DM, 64 * kb, 32 * nb, 32, nullptr, (f16*)(ws + WS_WBR) + (size_t)(32 * nb) * DM + 64 * kb, DM, scr, F.lane); continue; }
        r -= I_BR;
        if (r < I_BR) { const int nb = r % 32, kb = r / 32; tr_item(P.w_brb, DM, 64 * kb, 32 * nb, 32, nullptr, (f16*)(ws + WS_WBR) + (size_t)(32 * nb) * DM + 512 + 64 * kb, DM, scr, F.lane); continue; }
        r -= I_BR;
        if (r < I_O) { const int nb = r % 32, kb = r / 32; tr_item(P.w_o, DM, 64 * kb, 32 * nb, 32, nullptr, (f16*)(ws + WS_WO) + (size_t)(32 * nb) * DM + 64 * kb, DM, scr, F.lane); continue; }
        r -= I_O;
        if (r < I_GU) { const int nb = r % (NGU / 32), kb = r / (NGU / 32), n0 = 32 * nb, pn = n0 >> 8, bj = (n0 >> 7) & 1, j0 = n0 & 127;
            tr_item(bj ? P.w_up : P.w_gate, DFF, 64 * kb, 128 * pn + j0, 32, P.g_ffn, (f16*)(ws + WS_WGU) + (size_t)n0 * DM + 64 * kb, DM, scr, F.lane); continue; }
        r -= I_GU;
        { const int nb = r % 32, kb = r / 32; tr_item(P.w_down, DM, 64 * kb, 32 * nb, 32, nullptr, (f16*)(ws + WS_WDN) + (size_t)(32 * nb) * DFF + 64 * kb, DFF, scr, F.lane); }
    }
    float* rstd1 = (float*)(ws + WS_RSTD1);
    for (int m = gw; m < MT; m += NGW) {
        u32x2* o8 = (u32x2*)((f16*)(ws + WS_XH) + (size_t)m * DM) + F.lane;
        if (m < MR) {
            const float* xrow = m < MP ? P.x_p + (size_t)m * DM : P.x_s + (size_t)(m - MP) * DM;
            const f32x4* xr = (const f32x4*)xrow + F.lane;
            f32x4 v[4]; float s = 0.f;
#pragma unroll
            for (int j = 0; j < 4; ++j) { v[j] = xr[64 * j]; s += (v[j].x * v[j].x + v[j].y * v[j].y) + (v[j].z * v[j].z + v[j].w * v[j].w); }
            s = wave_sum(s);
            if (F.lane == 0) rstd1[m] = 1.0f / sqrtf(s * (1.0f / DM) + RMS_EPS);
#pragma unroll
            for (int j = 0; j < 4; ++j) o8[64 * j] = (u32x2){pkh(v[j].x, v[j].y), pkh(v[j].z, v[j].w)};
        } else {
            if (F.lane == 0) rstd1[m] = 0.f;
#pragma unroll
            for (int j = 0; j < 4; ++j) o8[64 * j] = (u32x2){0u, 0u};
        }
    }
    f32x2* rope = (f32x2*)(ws + WS_ROPE);
    for (int e = F.bx * (NWAVES * 64) + F.tid; e < NROPE * 32; e += F.G * NWAVES * 64) {
        const int p = e >> 5, i = e & 31, pos = p < SEQ ? p : PAST + (p - SEQ);
        const float inv = (float)exp2(-(double)i * (13.287712379549449 / 32.0));
        const float ang = (float)pos * inv;
        const double a = (double)ang, n = rint(a * 0.15915494309189535);
        double r = fma(-n, 6.283185307179586, a); r = fma(-n, 2.4492935982947064e-16, r);
        rope[e] = (f32x2){cosf((float)r), sinf((float)r)};
    }
}
__device__ __forceinline__ void ld8(const f32x4 (&a)[2], float* v) { v[0] = a[0][0]; v[1] = a[0][1]; v[2] = a[0][2]; v[3] = a[0][3]; v[4] = a[1][0]; v[5] = a[1][1]; v[6] = a[1][2]; v[7] = a[1][3]; }
__device__ __forceinline__ void st8f(float* p, const float* v) { *(f32x4*)p = (f32x4){v[0], v[1], v[2], v[3]}; *(f32x4*)(p + 4) = (f32x4){v[4], v[5], v[6], v[7]}; }
__device__ __forceinline__ void st8h(f16* p, const float* v) { *(u32x4*)p = pk8(v); }
__device__ __forceinline__ void ld8h(const f16* p, float* v) { const half8 h = *(const half8*)p;
#pragma unroll
    for (int i = 0; i < 8; ++i) v[i] = (float)h[i]; }

struct EpiInProj {
    const float* rstd; const f32x2* rope; float* out; unsigned char* ws;
    __device__ __forceinline__ bool zero_after(const pg8::Unit&) const { return true; }
    __device__ __forceinline__ void operator()(f32x4 (&acc)[2][2][4][2], const pg8::Unit& u, int wr, int wc, int fr, int fq) const {
        const int hs = 4 * u.pn + wc, d0 = 8 * fq;
        if (hs >= 78) return;
        bool do_rope = false; int func = 0  ;
        size_t o32p = 0, o32s = 0; int p32 = 0; bool has32 = false;
        f16* o16 = nullptr; int p16 = 0;
        if (hs < 8)        { do_rope = true; o16 = (f16*)(ws + WS_QA) + hs * 64; p16 = 512; }
        else if (hs < 10)  { do_rope = true; o16 = (f16*)(ws + WS_KA) + (hs - 8) * 64; p16 = 128; has32 = true; o32p = O_KVA_P + (hs - 8) * 64; o32s = O_KVA_S + (hs - 8) * 64; p32 = 256; }
        else if (hs < 12)  { o16 = (f16*)(ws + WS_VA) + (hs - 10) * 64; p16 = 128; has32 = true; o32p = O_KVA_P + 128 + (hs - 10) * 64; o32s = O_KVA_S + 128 + (hs - 10) * 64; p32 = 256; }
        else if (hs < 20)  { do_rope = true; o16 = (f16*)(ws + WS_QI) + (hs - 12) * 64; p16 = 512; }
        else if (hs == 20) { do_rope = true; o16 = (f16*)(ws + WS_KI); p16 = 64; has32 = true; o32p = O_KI_P; o32s = O_KI_S; p32 = 64; }
        else if (hs == 21) { func = 2; }
        else if (hs < 30)  { o16 = (f16*)(ws + WS_QB) + (hs - 22) * 64; p16 = 512; }
        else if (hs < 38)  { o16 = (f16*)(ws + WS_KB) + (hs - 30) * 64; p16 = 512; has32 = true; o32p = O_KVB_P + (hs - 30) * 64; o32s = O_KVB_S + (hs - 30) * 64; p32 = 1024; }
        else if (hs < 46)  { o16 = (f16*)(ws + WS_VB) + (hs - 38) * 64; p16 = 512; has32 = true; o32p = O_KVB_P + 512 + (hs - 38) * 64; o32s = O_KVB_S + 512 + (hs - 38) * 64; p32 = 1024; }
        else               { func = 1; o16 = (f16*)(ws + WS_G) + (hs - 46) * 64; p16 = 2048; }
#pragma unroll
        for (int ai = 0; ai < 2; ++ai)
#pragma unroll
            for (int m = 0; m < 4; ++m) { const int row = u.pm * 256 + ai * 128 + wr * 64 + m * 16 + fr; if (row >= MR) continue;
            const float rs = rstd[row];
            float v1[8], v2[8]; ld8(acc[ai][0][m], v1); ld8(acc[ai][1][m], v2);
#pragma unroll
            for (int i = 0; i < 8; ++i) { v1[i] *= rs; v2[i] *= rs; }
            if (func == 2) { if (fq == 0) { float* w = (float*)(ws + WS_WI) + (size_t)row * 8;
#pragma unroll
                for (int i = 0; i < 8; ++i) v1[i] *= 0.35355339059327373f; st8f(w, v1); } }
            else {
                if (do_rope) {
                    const int pidx = row < MP ? (row & (SEQ - 1)) : SEQ + ((row - MP) & (DECS - 1));
                    const f32x4* rp = (const f32x4*)(rope + (size_t)pidx * 32 + d0);
#pragma unroll
                    for (int j = 0; j < 4; ++j) { const f32x4 cs = rp[j];
                        const float a0 = v1[2 * j], b0 = v2[2 * j], a1 = v1[2 * j + 1], b1 = v2[2 * j + 1];
                        v1[2 * j] = a0 * cs[0] - b0 * cs[1]; v2[2 * j] = b0 * cs[0] + a0 * cs[1];
                        v1[2 * j + 1] = a1 * cs[2] - b1 * cs[3]; v2[2 * j + 1] = b1 * cs[2] + a1 * cs[3]; }
                }
                if (func == 1) {
#pragma unroll
                    for (int i = 0; i < 8; ++i) { v1[i] = fmaxf(1.0f / (1.0f + __expf(-v1[i])), 6.0e-8f); v2[i] = fmaxf(1.0f / (1.0f + __expf(-v2[i])), 6.0e-8f); }
                }
                if (has32) { float* o = out + (row < MP ? o32p + (size_t)row * p32 : o32s + (size_t)(row - MP) * p32) + d0; st8f(o, v1); st8f(o + 32, v2); }
                f16* oh = o16 + (size_t)row * p16 + d0; st8h(oh, v1); st8h(oh + 32, v2);
            }
            }
    }
};

struct EpiBranch {
    const f16* G; f16* MG;
    __device__ __forceinline__ bool zero_after(const pg8::Unit& u) const { return u.sub != 0; }
    __device__ __forceinline__ void operator()(f32x4 (&acc)[2][2][4][2], const pg8::Unit& u, int wr, int wc, int fr, int fq) const {
#pragma unroll
        for (int ai = 0; ai < 2; ++ai)
#pragma unroll
            for (int m = 0; m < 4; ++m) { const int row = u.pm * 256 + ai * 128 + wr * 64 + m * 16 + fr; if (row >= MR) continue;
#pragma unroll
            for (int bj = 0; bj < 2; ++bj) { const int col = u.pn * 256 + bj * 128 + wc * 32 + 8 * fq;
                float g1[8]; ld8h(G + (size_t)row * 2048 + 1024 + col, g1);
                if (u.sub == 0) { float g0[8]; ld8h(G + (size_t)row * 2048 + col, g0);
#pragma unroll
                    for (int i = 0; i < 8; ++i) acc[ai][bj][m][i >> 2][i & 3] *= g0[i] / g1[i];
                } else { float v[8]; ld8(acc[ai][bj][m], v);
#pragma unroll
                    for (int i = 0; i < 8; ++i) v[i] *= g1[i];
                    st8h(MG + (size_t)row * DM + col, v); }
            }
            }
    }
};

struct EpiWo {
    const float *x_p, *x_s; float* H; f16* HH; float* SS;
    __device__ __forceinline__ bool zero_after(const pg8::Unit&) const { return true; }
    __device__ __forceinline__ void operator()(f32x4 (&acc)[2][2][4][2], const pg8::Unit& u, int wr, int wc, int fr, int fq) const {
#pragma unroll
        for (int ai = 0; ai < 2; ++ai)
#pragma unroll
            for (int m = 0; m < 4; ++m) { const int row = u.pm * 256 + ai * 128 + wr * 64 + m * 16 + fr; float ss = 0.f;
                if (row < MR) { const float* xr = row < MP ? x_p + (size_t)row * DM : x_s + (size_t)(row - MP) * DM;
#pragma unroll
                    for (int bj = 0; bj < 2; ++bj) { const int col = u.pn * 256 + bj * 128 + wc * 32 + 8 * fq;
                        float v[8]; ld8(acc[ai][bj][m], v); const f32x4 x0 = *(const f32x4*)(xr + col), x1 = *(const f32x4*)(xr + col + 4);
#pragma unroll
                        for (int i = 0; i < 4; ++i) { v[i] += x0[i]; v[4 + i] += x1[i]; }
#pragma unroll
                        for (int i = 0; i < 8; ++i) ss += v[i] * v[i];
                        st8f(H + (size_t)row * DM + col, v); st8h(HH + (size_t)row * DM + col, v); } }
                ss += __shfl_xor(ss, 16); ss += __shfl_xor(ss, 32);
                if (fq == 0 && row < MR) SS[(size_t)row * 16 + u.pn * 4 + wc] = ss; }
    }
};

__device__ __forceinline__ float rstd_from_parts(const float* SS, int row) {
    const f32x4* p = (const f32x4*)(SS + (size_t)row * 16); const f32x4 a = p[0], b = p[1], c = p[2], d = p[3];
    const float s = ((a[0] + a[1]) + (a[2] + a[3])) + ((b[0] + b[1]) + (b[2] + b[3])) + ((c[0] + c[1]) + (c[2] + c[3])) + ((d[0] + d[1]) + (d[2] + d[3]));
    return 1.0f / sqrtf(s * (1.0f / DM) + RMS_EPS);
}

struct EpiGateUp {
    const float* SS; f16* ACT;
    __device__ __forceinline__ bool zero_after(const pg8::Unit&) const { return true; }
    __device__ __forceinline__ void operator()(f32x4 (&acc)[2][2][4][2], const pg8::Unit& u, int wr, int wc, int fr, int fq) const {
#pragma unroll
        for (int ai = 0; ai < 2; ++ai)
#pragma unroll
            for (int m = 0; m < 4; ++m) { const int row = u.pm * 256 + ai * 128 + wr * 64 + m * 16 + fr; if (row >= MR) continue;
            const float rs = rstd_from_parts(SS, row);
            float g[8], up[8], a[8]; ld8(acc[ai][0][m], g); ld8(acc[ai][1][m], up);
#pragma unroll
            for (int i = 0; i < 8; ++i) { const float gg = g[i] * rs; a[i] = gg * (up[i] * rs) / (1.0f + __expf(-gg)); }
            st8h(ACT + (size_t)row * DFF + u.pn * 128 + wc * 32 + 8 * fq, a);
            }
    }
};

struct EpiDown {
    const float* H; float* out; float* SS;
    __device__ __forceinline__ bool zero_after(const pg8::Unit&) const { return true; }
    __device__ __forceinline__ void operator()(f32x4 (&acc)[2][2][4][2], const pg8::Unit& u, int wr, int wc, int fr, int fq) const {
#pragma unroll
        for (int ai = 0; ai < 2; ++ai)
#pragma unroll
            for (int m = 0; m < 4; ++m) { const int row = u.pm * 256 + ai * 128 + wr * 64 + m * 16 + fr; float ss = 0.f;
                if (row < MR) { float* yr = out + (row < MP ? O_Y_P + (size_t)row * DM : O_Y_S + (size_t)(row - MP) * DM);
#pragma unroll
                    for (int bj = 0; bj < 2; ++bj) { const int col = u.pn * 256 + bj * 128 + wc * 32 + 8 * fq;
                        float v[8]; ld8(acc[ai][bj][m], v); const f32x4 h0 = *(const f32x4*)(H + (size_t)row * DM + col), h1 = *(const f32x4*)(H + (size_t)row * DM + col + 4);
#pragma unroll
                        for (int i = 0; i < 4; ++i) { v[i] += h0[i]; v[4 + i] += h1[i]; }
#pragma unroll
                        for (int i = 0; i < 8; ++i) ss += v[i] * v[i];
                        st8f(yr + col, v); } }
                ss += __shfl_xor(ss, 16); ss += __shfl_xor(ss, 32);
                if (fq == 0 && row < MR) SS[(size_t)row * 16 + u.pn * 4 + wc] = ss; }
    }
};
constexpr int SCP_P = 8224, SCP_S = 16448, HIST_OFF = 131584, IDXL_OFF = HIST_OFF + 8192, IDXL_PITCH = 544, WBUF = 9216, VPITCH = 144;
static_assert(IDXL_OFF + 16 * IDXL_PITCH <= MISC_OFF && 8 * WBUF <= HIST_OFF && 16 * SCP_P <= HIST_OFF && 4 * SCP_S <= HIST_OFF, "attention LDS map");
constexpr float LOG2E = 1.4426950408889634f, LN2 = 0.6931471805599453f;

__device__ __forceinline__ f32x4 mfma16(half8 a, half8 b, f32x4 c) { return __builtin_amdgcn_mfma_f32_16x16x32_f16(a, b, c, 0, 0, 0); }
__device__ __forceinline__ f32x16 mfma32(half8 a, half8 b, f32x16 c) { return __builtin_amdgcn_mfma_f32_32x32x16_f16(a, b, c, 0, 0, 0); }
__device__ __forceinline__ half8 cvt8(f32x4 a, f32x4 b) { half8 h; h[0] = (f16)a[0]; h[1] = (f16)a[1]; h[2] = (f16)a[2]; h[3] = (f16)a[3]; h[4] = (f16)b[0]; h[5] = (f16)b[1]; h[6] = (f16)b[2]; h[7] = (f16)b[3]; return h; }
template <int OFF> __device__ __forceinline__ half4 tr_read(unsigned lds_addr) { s16x4 r; asm volatile("ds_read_b64_tr_b16 %0, %1 offset:%2\n\ts_waitcnt lgkmcnt(0)" : "=&v"(r) : "v"(lds_addr), "n"(OFF) : "memory"); return __builtin_bit_cast(half4, r); }
#define LAUNDER(x) asm volatile("" : "+v"(x))
__device__ __forceinline__ half8 cat4(half4 lo, half4 hi) { return __builtin_shufflevector(lo, hi, 0, 1, 2, 3, 4, 5, 6, 7); }
__device__ __forceinline__ unsigned lds_addr_of(LAS const void* p) { return (unsigned)(size_t)p; }
__device__ __forceinline__ unsigned tokey(unsigned h) { return (h & 0x8000u) ? (~h & 0xFFFFu) : (h | 0x8000u); }

__device__ __forceinline__ void find_bin(LAS unsigned* hist, unsigned need, int lane, unsigned& bin, unsigned& above) {
    const u32x4 c = *(LAS u32x4*)(hist + 4 * lane);
    const unsigned s = c.x + c.y + c.z + c.w; unsigned S = s;
#pragma unroll
    for (int off = 1; off < 64; off <<= 1) { const unsigned t = __shfl_down(S, off); if (lane + off < 64) S += t; }
    const unsigned ab = S - s;
    const unsigned long long mk = __ballot((ab < need) && (S >= need));
    const int L = mk ? __ffsll((long long)mk) - 1 : 0;
    unsigned cum = ab, b = 4 * lane, a = ab; bool found = false;
#pragma unroll
    for (int e = 3; e >= 0; --e) { const unsigned ce = c[e]; if (!found && cum + ce >= need) { b = 4 * lane + e; a = cum; found = true; } cum += ce; }
    bin = __shfl(b, L); above = __shfl(a, L);
}
__device__ __forceinline__ int topk_select(LAS const unsigned short* row, int n, LAS unsigned* hist, LAS unsigned short* idxo, int lane) {
    LAUNDER(lane);
    if (n <= TOPK) { for (int i = lane; i < n; i += 64) idxo[i] = (unsigned short)i; LDS_WAIT(); return n; }
    unsigned B1 = 0, ab1 = 0, B2 = 0, ab2 = 0;
#pragma unroll 1
    for (int pass = 0; pass < 2; ++pass) {
        *(LAS u32x4*)(hist + 4 * lane) = (u32x4){0u, 0u, 0u, 0u};
        LDS_WAIT(); asm volatile("" ::: "memory");
#pragma unroll 1
        for (int base = 0; base < n; base += 512) { const int i0 = base + 8 * lane;
            if (i0 < n) { const u32x4 v = *(LAS const u32x4*)(row + i0);
#pragma unroll
                for (int e = 0; e < 8; ++e) { const unsigned h = (v[e >> 1] >> (16 * (e & 1))) & 0xFFFFu, k = tokey(h);
                    const bool ok = (i0 + e < n) && (pass == 0 || (k >> 8) == B1);
                    if (ok) __hip_atomic_fetch_add(hist + (pass == 0 ? (k >> 8) : (k & 255u)), 1u, __ATOMIC_RELAXED, __HIP_MEMORY_SCOPE_WORKGROUP); } } }
        LDS_WAIT(); asm volatile("" ::: "memory");
        if (pass == 0) find_bin(hist, (unsigned)TOPK, lane, B1, ab1); else find_bin(hist, (unsigned)TOPK - ab1, lane, B2, ab2);
        LDS_WAIT(); asm volatile("" ::: "memory");
    }
    const unsigned T = (B1 << 8) | B2, r2 = (unsigned)TOPK - ab1 - ab2;
    int pos = 0; unsigned ties = 0;
    const unsigned long long lt = (1ull << lane) - 1ull;
#pragma unroll 1
    for (int base = 0; base < n; base += 64) { const int i = base + lane; const bool in = i < n;
        const unsigned k = in ? tokey(row[i]) : 0u;
        const bool gt = in && k > T, eq = in && k == T;
        const unsigned long long em = __ballot(eq);
        const bool sel = gt || (eq && ties + (unsigned)__popcll(em & lt) < r2);
        const unsigned long long sm = __ballot(sel);
        if (sel) idxo[pos + __popcll(sm & lt)] = (unsigned short)i;
        pos += __popcll(sm); ties += (unsigned)__popcll(em); }
    LDS_WAIT();
    return pos;
}

struct KvSrc {
    const f16 *KA, *VA; const float* cache; const int* pt; int rowbase;
};
template <bool SAMPLE> __device__ __forceinline__ half8 kv_load8(const KvSrc& S, int key, int kv, int c, int d) {
    if (SAMPLE && key < PAST) { const size_t ri = (size_t)S.pt[key >> 7] * PAGE + (key & (PAGE - 1)); const float* p = S.cache + ri * 256 + kv * 128 + c * 64 + d;
        return cvt8(*(const f32x4*)p, *(const f32x4*)(p + 4)); }
    const int r = SAMPLE ? S.rowbase + (key - PAST) : S.rowbase + key;
    return *(const half8*)((kv ? S.VA : S.KA) + (size_t)r * 128 + c * 64 + d);
}
template <bool SAMPLE> __device__ __forceinline__ void dsa_pair(const KvSrc& S, LAS const unsigned short* idx, int cnt, const f16* QA, int qrow, int c, LAS unsigned char* vbuf, f16* OAB, int lane) {
    LAUNDER(lane);
    const int fr = lane & 15, fq = lane >> 4;
    half8 B0, B1;
#pragma unroll
    for (int i = 0; i < 8; ++i) { B0[i] = (f16)0.f; B1[i] = (f16)0.f; }
    if (fr < 4) { const f16* q = QA + (size_t)qrow * 512 + (4 * c + fr) * 64; B0 = *(const half8*)(q + 8 * fq); B1 = *(const half8*)(q + 32 + 8 * fq); }
    f32x4 s[16];
#pragma unroll
    for (int g = 0; g < 16; ++g) { const int slot = 16 * g + fr, key = idx[slot < cnt ? slot : cnt - 1];
        const half8 A0 = kv_load8<SAMPLE>(S, key, 0, c, 8 * fq), A1 = kv_load8<SAMPLE>(S, key, 0, c, 32 + 8 * fq);
        s[g] = mfma16(A0, B0, (f32x4){0.f, 0.f, 0.f, 0.f}); s[g] = mfma16(A1, B1, s[g]);
        if ((g & 3) == 3) asm volatile("" ::: "memory"); }
    float mx = -INFINITY;
#pragma unroll
    for (int g = 0; g < 16; ++g)
#pragma unroll
        for (int e = 0; e < 4; ++e) { const float v = (16 * g + 4 * fq + e < cnt) ? s[g][e] * (0.125f * LOG2E) : -INFINITY; s[g][e] = v; mx = fmaxf(mx, v); }
    mx = fmaxf(mx, __shfl_xor(mx, 16)); mx = fmaxf(mx, __shfl_xor(mx, 32));
    float l = 0.f;
#pragma unroll
    for (int g = 0; g < 16; ++g)
#pragma unroll
        for (int e = 0; e < 4; ++e) { const float p = __builtin_amdgcn_exp2f(s[g][e] - mx); s[g][e] = p; l += p; }
    l += __shfl_xor(l, 16); l += __shfl_xor(l, 32);
    f32x4 o[4];
#pragma unroll
    for (int dt = 0; dt < 4; ++dt) o[dt] = (f32x4){0.f, 0.f, 0.f, 0.f};
    const unsigned vb = lds_addr_of(vbuf) + (unsigned)((4 * fq + (fr >> 2)) * VPITCH + (fr & 3) * 8);
    LAS unsigned char* vw = vbuf + (lane >> 3) * VPITCH + (lane & 7) * 16;
#pragma unroll
    for (int ch = 0; ch < 4; ++ch) {
#pragma unroll
        for (int i = 0; i < 8; ++i) { const int r = (lane >> 3) + 8 * i, cc = lane & 7, slot = 64 * ch + r, key = idx[slot < cnt ? slot : cnt - 1];
            *(LAS half8*)(vw + 8 * i * VPITCH) = kv_load8<SAMPLE>(S, key, 1, c, 8 * cc); }
        LDS_WAIT(); asm volatile("" ::: "memory");
#pragma unroll
        for (int ksl = 0; ksl < 2; ++ksl) { const int ks = 2 * ch + ksl;
            half8 pf;
#pragma unroll
            for (int j = 0; j < 4; ++j) { pf[j] = (f16)s[2 * ks][j]; pf[4 + j] = (f16)s[2 * ks + 1][j]; }
#define DSA_PV(dt) { const half4 lo = ksl ? tr_read<32 * VPITCH + 32 * (dt)>(vb) : tr_read<32 * (dt)>(vb), hi = ksl ? tr_read<48 * VPITCH + 32 * (dt)>(vb) : tr_read<16 * VPITCH + 32 * (dt)>(vb); o[dt] = mfma16(cat4(lo, hi), pf, o[dt]); }
            DSA_PV(0) DSA_PV(1) DSA_PV(2) DSA_PV(3)
#undef DSA_PV
        }
        asm volatile("" ::: "memory");
    }
    if (fr < 4) { const float il = 1.0f / l; f16* op = OAB + (size_t)qrow * 1024 + (4 * c + fr) * 64 + 4 * fq;
#pragma unroll
        for (int dt = 0; dt < 4; ++dt) *(u32x2*)(op + 16 * dt) = (u32x2){pkh(o[dt][0] * il, o[dt][1] * il), pkh(o[dt][2] * il, o[dt][3] * il)}; }
}

template <bool SAMPLE> __device__ __forceinline__ void idx_unit(const Frame& F, const Params& P, int bs, int tt) {
    unsigned char* ws = P.ws;
    int lane = F.lane; LAUNDER(lane);
    const int wave = F.wave, fr = lane & 15, fq = lane >> 4;
    const f16* QI = (const f16*)(ws + WS_QI); const f16* KI = (const f16*)(ws + WS_KI); const float* WI = (const float*)(ws + WS_WI);
    const int t0 = SAMPLE ? 0 : 16 * tt, rowbase = SAMPLE ? MP + 4 * bs : bs * SEQ;
    const int qrow_l = SAMPLE ? rowbase + (fr < 4 ? fr : 3) : rowbase + t0 + fr;
    constexpr int SCP = SAMPLE ? SCP_S : SCP_P;
    {
        half8 Bq[8][2]; float w[8];
#pragma unroll
        for (int h = 0; h < 8; ++h) { const f16* q = QI + (size_t)qrow_l * 512 + h * 64; Bq[h][0] = *(const half8*)(q + 8 * fq); Bq[h][1] = *(const half8*)(q + 32 + 8 * fq); w[h] = WI[(size_t)qrow_l * 8 + h] * 0.125f; }
        const int ng = SAMPLE ? (PAST / 16 + 1) : tt + 1;
        const int* pt = P.pt + bs * NPAGES;
#pragma unroll 1
        for (int g = wave; g < ng; g += NWAVES) {
            half8 A0, A1;
            if (SAMPLE && g < PAST / 16) { const int key = 16 * g + fr; const size_t ri = (size_t)pt[key >> 7] * PAGE + (key & (PAGE - 1)); const float* p = P.c_ki + ri * 64 + 8 * fq;
                A0 = cvt8(*(const f32x4*)p, *(const f32x4*)(p + 4)); A1 = cvt8(*(const f32x4*)(p + 32), *(const f32x4*)(p + 36)); }
            else { const int r = SAMPLE ? rowbase + (fr < 4 ? fr : 3) : rowbase + 16 * g + fr; const f16* k = KI + (size_t)r * 64 + 8 * fq; A0 = *(const half8*)k; A1 = *(const half8*)(k + 32); }
            f32x4 sc = (f32x4){0.f, 0.f, 0.f, 0.f};
#pragma unroll
            for (int h = 0; h < 8; ++h) { f32x4 s = mfma16(A0, Bq[h][0], (f32x4){0.f, 0.f, 0.f, 0.f}); s = mfma16(A1, Bq[h][1], s);
#pragma unroll
                for (int e = 0; e < 4; ++e) sc[e] = fmaf(w[h], fmaxf(s[e], 0.f), sc[e]); }
            if (!SAMPLE || fr < 4) *(LAS u32x2*)(F.lds + fr * SCP + (16 * g + 4 * fq) * 2) = (u32x2){pkh(sc[0], sc[1]), pkh(sc[2], sc[3])};
        }
    }
    LDS_WAIT(); __syncthreads();
    LAS unsigned* hist = (LAS unsigned*)(F.lds + HIST_OFF + wave * 1024);
#pragma unroll 1
    for (int qi = wave; qi < (SAMPLE ? 4 : 16); qi += NWAVES) {
        LAS unsigned short* io = (LAS unsigned short*)(F.lds + IDXL_OFF + qi * IDXL_PITCH);
        const int n = SAMPLE ? PAST + qi + 1 : t0 + qi + 1;
        const int cnt = topk_select((LAS const unsigned short*)(F.lds + qi * SCP), n, hist, io, lane);
        if (lane == 0) io[256] = (unsigned short)cnt;
    }
    LDS_WAIT(); __syncthreads();
    KvSrc S; S.KA = (const f16*)(ws + WS_KA); S.VA = (const f16*)(ws + WS_VA); S.cache = P.c_kva; S.pt = P.pt + bs * NPAGES; S.rowbase = rowbase;
#pragma unroll 1
    for (int p = wave; p < (SAMPLE ? 8 : 32); p += NWAVES) { const int qi = p >> 1, c = p & 1;
        LAS const unsigned short* io = (LAS const unsigned short*)(F.lds + IDXL_OFF + qi * IDXL_PITCH);
        const int cnt = io[256];
        dsa_pair<SAMPLE>(S, io, cnt, (const f16*)(ws + WS_QA), rowbase + t0 + qi, c, F.lds + wave * WBUF, (f16*)(ws + WS_OAB), lane);
    }
}

__device__ __forceinline__ int crow(int reg, int h) { return (reg & 3) + 8 * (reg >> 2) + 4 * h; }
template <bool SAMPLE> __device__ __forceinline__ void sb_item(const Params& P, int bs, int h, int qt, LAS unsigned char* buf, int lane) {
    unsigned char* ws = P.ws;
    const f16* QB = (const f16*)(ws + WS_QB); const f16* KB = (const f16*)(ws + WS_KB); const f16* VB = (const f16*)(ws + WS_VB);
    LAUNDER(lane);
    const int r = lane & 31, h2 = lane >> 5;
    const int qpos = SAMPLE ? PAST + (r < 4 ? r : 3) : 32 * qt + r;
    const int qrow = SAMPLE ? MP + 4 * bs + (r < 4 ? r : 3) : bs * SEQ + qpos;
    half8 Bq[4];
#pragma unroll
    for (int ks = 0; ks < 4; ++ks) Bq[ks] = *(const half8*)(QB + (size_t)qrow * 512 + h * 64 + 16 * ks + 8 * h2);
    f32x16 O0, O1;
#pragma unroll
    for (int i = 0; i < 16; ++i) { O0[i] = 0.f; O1[i] = 0.f; }
    float carry = 0.f;
    LAS unsigned char* kb = buf; LAS unsigned char* vbp = buf + 32 * VPITCH;
    const unsigned vb = lds_addr_of(vbp) + (unsigned)((4 * h2 + ((lane & 15) >> 2)) * VPITCH + (16 * ((lane >> 4) & 1) + 4 * (lane & 3)) * 2);
    const int* pt = P.pt + bs * NPAGES;
#pragma unroll 1
    for (int tile = SAMPLE ? PAST / 32 : qt; tile >= 0; --tile) {
        const int p0 = 32 * tile;
        if (SAMPLE && tile < PAST / 32) {
            const size_t ri0 = (size_t)pt[p0 >> 7] * PAGE + (p0 & (PAGE - 1));
#pragma unroll
            for (int i = 0; i < 8; ++i) { const int id = lane + 64 * i, kk = id >> 4, cc = id & 15; const float* kp = P.c_kvb + ((ri0 + kk) * 2) * 512 + h * 64 + 4 * cc;
                const f32x4 kf = *(const f32x4*)kp, vf = *(const f32x4*)(kp + 512);
                *(LAS u32x2*)(kb + kk * VPITCH + cc * 8) = (u32x2){pkh(kf[0], kf[1]), pkh(kf[2], kf[3])};
                *(LAS u32x2*)(vbp + kk * VPITCH + cc * 8) = (u32x2){pkh(vf[0], vf[1]), pkh(vf[2], vf[3])}; }
        } else {
#pragma unroll
            for (int i = 0; i < 4; ++i) { const int id = lane + 64 * i, kk = id >> 3, cc = id & 7;
                const int row = SAMPLE ? MP + 4 * bs + (kk < 4 ? kk : 3) : bs * SEQ + p0 + kk;
                *(LAS half8*)(kb + kk * VPITCH + cc * 16) = *(const half8*)(KB + (size_t)row * 512 + h * 64 + 8 * cc);
                *(LAS half8*)(vbp + kk * VPITCH + cc * 16) = *(const half8*)(VB + (size_t)row * 512 + h * 64 + 8 * cc); }
        }
        LDS_WAIT(); asm volatile("" ::: "memory");
        f32x16 s;
#pragma unroll
        for (int i = 0; i < 16; ++i) s[i] = 0.f;
#pragma unroll
        for (int ks = 0; ks < 4; ++ks) s = mfma32(*(LAS const half8*)(kb + r * VPITCH + (16 * ks + 8 * h2) * 2), Bq[ks], s);
        float sp[16], gs[4], pg[4];
#pragma unroll
        for (int i = 0; i < 16; ++i) { const float z = s[i] * 0.125f; const bool valid = p0 + crow(i, h2) < qpos;
            const float e = __builtin_amdgcn_exp2f(-fabsf(z) * LOG2E);
            const float v = fmaxf(z, 0.f) + __builtin_amdgcn_logf(1.0f + e) * LN2;
            sp[i] = valid ? v : 0.f; s[i] = valid ? z : -INFINITY; }
#pragma unroll
        for (int gi = 0; gi < 4; ++gi) { gs[gi] = (sp[4 * gi] + sp[4 * gi + 1]) + (sp[4 * gi + 2] + sp[4 * gi + 3]); pg[gi] = __shfl_xor(gs[gi], 32); }
        float base = carry;
        float a[16];
#pragma unroll
        for (int gi = 3; gi >= 0; --gi) { float c = base + (h2 == 0 ? pg[gi] : 0.f);
#pragma unroll
            for (int e = 3; e >= 0; --e) { c += sp[4 * gi + e]; a[4 * gi + e] = __builtin_amdgcn_exp2f((s[4 * gi + e] - c) * LOG2E); }
            base += gs[gi] + pg[gi]; }
        carry = base;
#pragma unroll
        for (int s2 = 0; s2 < 2; ++s2) { half8 pf;
#pragma unroll
            for (int j = 0; j < 8; ++j) pf[j] = (f16)a[8 * s2 + j];
            { const half4 lo = s2 ? tr_read<16 * VPITCH>(vb) : tr_read<0>(vb), hi = s2 ? tr_read<24 * VPITCH>(vb) : tr_read<8 * VPITCH>(vb);
              O0 = mfma32(cat4(lo, hi), pf, O0); }
            { const half4 lo = s2 ? tr_read<16 * VPITCH + 64>(vb) : tr_read<64>(vb), hi = s2 ? tr_read<24 * VPITCH + 64>(vb) : tr_read<8 * VPITCH + 64>(vb);
              O1 = mfma32(cat4(lo, hi), pf, O1); } }
        asm volatile("" ::: "memory");
        if (__all(carry >= 104.0f)) break;
    }
    if (!SAMPLE || r < 4) { f16* op = (f16*)(ws + WS_OAB) + (size_t)qrow * 1024 + 512 + h * 64 + 4 * h2;
#pragma unroll
        for (int gi = 0; gi < 4; ++gi) {
            *(u32x2*)(op + 8 * gi) = (u32x2){pkh(O0[4 * gi], O0[4 * gi + 1]), pkh(O0[4 * gi + 2], O0[4 * gi + 3])};
            *(u32x2*)(op + 32 + 8 * gi) = (u32x2){pkh(O1[4 * gi], O1[4 * gi + 1]), pkh(O1[4 * gi + 2], O1[4 * gi + 3])}; } }
}

constexpr int NU_SIDX = DECB, NU_SSB = DECB, NU_PIDX = NB * (SEQ / 16), NU_PSB = NB * (SEQ / 32), NU_ALL = NU_SIDX + NU_SSB + NU_PIDX + NU_PSB;
__device__ __forceinline__ void p2_attention(const Frame& F, const Params& P) {
    for (;;) {
        __syncthreads();
        if (F.tid == 0) F.MISC[16] = __hip_atomic_fetch_add(F.ctl + CW_QUEUE, 1u, RLX_AGENT);
        __syncthreads();
        int u = (int)F.MISC[16];
        if (u >= NU_ALL) break;
#ifndef NO_SIDX
        if (u < NU_SIDX) { idx_unit<true>(F, P, u, 0); continue; }
#endif
        u -= NU_SIDX;
#ifndef NO_SSB
        if (u < NU_SSB) { sb_item<true>(P, u, F.wave, 0, F.lds + F.wave * WBUF, F.lane); continue; }
#endif
        u -= NU_SSB;
#ifndef NO_PIDX
        if (u < NU_PIDX) { idx_unit<false>(F, P, u & 3, SEQ / 16 - 1 - (u >> 2)); continue; }
#endif
        u -= NU_PIDX;
#ifndef NO_PSB
        sb_item<false>(P, u & 3, F.wave, SEQ / 32 - 1 - (u >> 2), F.lds + F.wave * WBUF, F.lane);
#endif
    }
}
__device__ __forceinline__ void p7_final(const Frame& F, const Params& P) {
    const float* SS = (const float*)(P.ws + WS_SS3);
    const int gw = F.bx * NWAVES + F.wave, NGW = F.G * NWAVES;
    for (int m = gw; m < MR; m += NGW) {
        const float rs = rstd_from_parts(SS, m);
        f32x4* yr = (f32x4*)(P.out + (m < MP ? O_Y_P + (size_t)m * DM : O_Y_S + (size_t)(m - MP) * DM)) + F.lane;
        const f32x4* gf = (const f32x4*)P.g_final + F.lane;
#pragma unroll
        for (int j = 0; j < 4; ++j) { const f32x4 v = yr[64 * j], g = gf[64 * j]; yr[64 * j] = (f32x4){v[0] * rs * g[0], v[1] * rs * g[1], v[2] * rs * g[2], v[3] * rs * g[3]}; }
    }
}

constexpr int N_PHASES = 8;
__global__ void __launch_bounds__(NWAVES * 64, 2) fwd(Params P) {
    extern __shared__ __attribute__((aligned(16))) unsigned char lds_raw[];
    Frame F;
    F.lds = (LAS unsigned char*)lds_raw;
    F.MISC = (volatile LAS unsigned*)(F.lds + MISC_OFF);
    F.tid = threadIdx.x; F.lane = F.tid & 63; F.wave = __builtin_amdgcn_readfirstlane(F.tid >> 6);
    F.G = gridDim.x; F.bx = blockIdx.x;
    F.ctl = (unsigned*)(P.ws + WS_CTL);
    if (F.tid < 64) F.MISC[F.tid] = 0u;
    __syncthreads();
    const bool multi = (P.ph_hi - P.ph_lo) > 1;
    XcdBarrier bar; bar.bar = F.ctl + CW_BAR; bar.x = 0; bar.st = nullptr;
    if (multi) bar = xcd_barrier_post(F.ctl + CW_BAR, F.MISC + 8);
    unsigned char* ws = P.ws;
    const int lo = P.ph_lo, hi = P.ph_hi;
#ifndef PHMASK
#define PHMASK 0xFF
#endif
#define IN(k) (((PHMASK >> (k)) & 1) && lo <= (k) && (k) < hi)
#define SEAM(k) do { if (IN(k) && IN((k) + 1)) xcd_barrier(bar); } while (0)

    if (IN(0)) { p0_prologue(F, P); SEAM(0); }
    if (IN(1)) {
        pg8::Gemm g{(const f16*)(ws + WS_XH), (const f16*)(ws + WS_WIN), DM, DM, DM}; pg8::StaticOrder S; S.init(MT, NIN, F.G, F.bx);
        EpiInProj E{(const float*)(ws + WS_RSTD1), (const f32x2*)(ws + WS_ROPE), P.out, ws};
        pg8::gemm_phase<EpiInProj, pg8::StaticOrder, true>(F.lds, g, S, E);
        SEAM(1);
    }
    if (IN(2)) { p2_attention(F, P); SEAM(2); }
    if (IN(3)) {
        pg8::Gemm g{(const f16*)(ws + WS_OAB), (const f16*)(ws + WS_WBR), DM, DM, 512}; pg8::PairOrder S; S.S.init(MT, DM, F.G, F.bx); S.K = 512;
        EpiBranch E{(const f16*)(ws + WS_G), (f16*)(ws + WS_MG)};
        pg8::gemm_phase<EpiBranch, pg8::PairOrder, false>(F.lds, g, S, E);
        SEAM(3);
    }
    if (IN(4)) {
        pg8::Gemm g{(const f16*)(ws + WS_MG), (const f16*)(ws + WS_WO), DM, DM, DM}; pg8::StaticOrder S; S.init(MT, DM, F.G, F.bx);
        EpiWo E{P.x_p, P.x_s, (float*)(ws + WS_H), (f16*)(ws + WS_HH), (float*)(ws + WS_SS2)};
        pg8::gemm_phase<EpiWo, pg8::StaticOrder, false>(F.lds, g, S, E);
        SEAM(4);
    }
    if (IN(5)) {
        pg8::Gemm g{(const f16*)(ws + WS_HH), (const f16*)(ws + WS_WGU), DM, DM, DM}; pg8::StaticOrder S; S.init(MT, NGU, F.G, F.bx);
        EpiGateUp E{(const float*)(ws + WS_SS2), (f16*)(ws + WS_ACT)};
        pg8::gemm_phase<EpiGateUp, pg8::StaticOrder, true>(F.lds, g, S, E);
        SEAM(5);
    }
    if (IN(6)) {
        pg8::Gemm g{(const f16*)(ws + WS_ACT), (const f16*)(ws + WS_WDN), DFF, DFF, DFF}; pg8::StaticOrder S; S.init(MT, DM, F.G, F.bx);
        EpiDown E{(const float*)(ws + WS_H), P.out, (float*)(ws + WS_SS3)};
        pg8::gemm_phase<EpiDown, pg8::StaticOrder, false>(F.lds, g, S, E);
        SEAM(6);
    }
    if (IN(7)) p7_final(F, P);
#undef IN
#undef SEAM
}

#ifndef MK_N_LAUNCHES
#define MK_N_LAUNCHES 1
#endif
extern "C" void kernel_launch(void* const* d_in, const int* in_sizes, int n_in, void* d_out, int out_size, void* d_ws, size_t ws_size, hipStream_t stream) {
    static int grid = 0;
    if (grid == 0) {
        if (n_in != 16 || out_size != (int)O_END || ws_size < WS_END) { fprintf(stderr, "kernel_launch: unexpected sizes (n_in %d, out %d, ws %zu, need %zu)\n", n_in, out_size, ws_size, (size_t)WS_END); grid = -1; return; }
        int dev = 0, cus = 0, per_cu = 0;
        if (hipGetDevice(&dev) != hipSuccess || hipDeviceGetAttribute(&cus, hipDeviceAttributeMultiprocessorCount, dev) != hipSuccess) { grid = -1; return; }
        if (hipFuncSetAttribute((const void*)fwd, hipFuncAttributeMaxDynamicSharedMemorySize, LDS_BYTES) != hipSuccess) { fprintf(stderr, "kernel_launch: hipFuncSetAttribute failed\n"); grid = -1; return; }
        if (hipOccupancyMaxActiveBlocksPerMultiprocessor(&per_cu, (const void*)fwd, NWAVES * 64, LDS_BYTES) != hipSuccess || per_cu < 1) { fprintf(stderr, "kernel_launch: occupancy query says %d\n", per_cu); }
        (void)hipGetLastError();
        grid = cus;
    }
    if (grid < 0) return;
    (void)hipMemsetAsync((char*)d_ws + WS_CTL, 0, CTL_ZERO_BYTES, stream);
    Params p{};
    p.x_p = (const float*)d_in[0]; p.x_s = (const float*)d_in[1]; p.c_kva = (const float*)d_in[2]; p.c_ki = (const float*)d_in[3]; p.c_kvb = (const float*)d_in[4]; p.pt = (const int*)d_in[5];
    p.w_in = (const float*)d_in[6]; p.w_bra = (const float*)d_in[7]; p.w_brb = (const float*)d_in[8]; p.w_o = (const float*)d_in[9]; p.g_attn = (const float*)d_in[10]; p.g_ffn = (const float*)d_in[11];
    p.w_gate = (const float*)d_in[12]; p.w_up = (const float*)d_in[13]; p.w_down = (const float*)d_in[14]; p.g_final = (const float*)d_in[15];
    p.out = (float*)d_out; p.ws = (unsigned char*)d_ws;
#if MK_N_LAUNCHES == 1
    p.ph_lo = 0; p.ph_hi = N_PHASES;
    hipLaunchKernelGGL(fwd, dim3(grid), dim3(NWAVES * 64), LDS_BYTES, stream, p);
#else
    for (int k = 0; k < N_PHASES; ++k) { p.ph_lo = k; p.ph_hi = k + 1; hipLaunchKernelGGL(fwd, dim3(grid), dim3(NWAVES * 64), LDS_BYTES, stream, p); }
#endif
}
```

```cpp
#include <hip/hip_runtime.h>
#include <cstdio>
#include <cstdint>

#define LAS __attribute__((address_space(3)))
#define GAS __attribute__((address_space(1)))
typedef _Float16 f16;
typedef _Float16 half8 __attribute__((ext_vector_type(8)));
typedef _Float16 half4 __attribute__((ext_vector_type(4)));
typedef _Float16 half2v __attribute__((ext_vector_type(2)));
typedef float f32x2 __attribute__((ext_vector_type(2)));
typedef float f32x4 __attribute__((ext_vector_type(4)));
typedef float f32x16 __attribute__((ext_vector_type(16)));
typedef unsigned u32x4 __attribute__((ext_vector_type(4)));
typedef unsigned u32x2 __attribute__((ext_vector_type(2)));
typedef short s16x4 __attribute__((ext_vector_type(4)));

namespace pg8 {
constexpr int BM = 256, BK = 64, HALF = 128, HTB = HALF * BK * 2  , STAGE_BYTES = 8 * HTB, NXCD = 8, WGM = 8;

__host__ __device__ __forceinline__ int lds_byte(int r, int c) { const int st = (r >> 4) * 2 + (c >> 5), rr = r & 15, cc = c & 31, ob = rr * 64 + cc * 2; return st * 1024 + (ob ^ (((ob >> 9) & 1) << 5)); }
__host__ __device__ __forceinline__ void stage_rc(int b, int& R, int& C) { const int st = b / 1024, sb = b % 1024, swz = sb ^ (((sb >> 9) & 1) << 5); R = (st >> 1) * 16 + swz / 64; C = (st & 1) * 32 + (swz % 64) / 2; }
__host__ __device__ __forceinline__ int perm32(int rho) { const int n = rho >> 4, i = rho & 15; return 8 * (i >> 2) + 4 * n + (i & 3); }

struct Unit { int pm, pn, ka, kb, sub; };
struct Gemm { const f16* A; const f16* Bt; int lda, ldb, K; };

struct StaticOrder {
    int nM, nN, nwg, G, c;
    __host__ __device__ void init(int M, int N, int G_, int c_) { nM = M / BM; nN = N / BM; nwg = nM * nN; G = G_; c = c_; }
    __host__ __device__ bool next(int i, Unit& u) const {
        const long L = (long)i * G + c; if (L >= nwg) return false;
        int wgid = (int)L; { const int q = nwg / NXCD, r = nwg % NXCD, xcd = wgid % NXCD, off = wgid / NXCD; wgid = (xcd < r ? xcd * (q + 1) : r * (q + 1) + (xcd - r) * q) + off; }
        const int nig = WGM * nN, gid = wgid / nig, fm = gid * WGM, gsz = (nM - fm) < WGM ? (nM - fm) : WGM;
        u.pm = fm + ((wgid % nig) % gsz); u.pn = (wgid % nig) / gsz; u.ka = 0; u.kb = 0; u.sub = 1; return true;
    }
};
struct PairOrder {
    StaticOrder S; int K;
    __host__ __device__ bool next(int i, Unit& u) const { if (!S.next(i >> 1, u)) return false; u.sub = i & 1; u.ka = u.kb = (i & 1) * K; return true; }
};

template <class Epi, class Sched, bool ALIGN_EPI = false>
__device__ __forceinline__ void gemm_phase(LAS unsigned char* lds, const Gemm g, const Sched& S, const Epi& E) {
    const int tid = threadIdx.x, wid = __builtin_amdgcn_readfirstlane(tid >> 6), lane = tid & 63, wr = wid >> 2, wc = wid & 3, fr = lane & 15, fq = lane >> 4;
    const int nt = g.K / BK;
    unsigned voffA[2], voffB[2];
#pragma unroll
    for (int i = 0; i < 2; ++i) { int R, C; stage_rc(tid * 16 + i * 8192, R, C); const int Rb = (R & ~31) + perm32(R & 31);
        voffA[i] = (unsigned)(R * g.lda + C) * 2u; voffB[i] = (unsigned)(Rb * g.ldb + C) * 2u; }
    const size_t kstep = (size_t)(BK * 2);
    const size_t hstepA = (size_t)HALF * g.lda * 2, hstepB = (size_t)HALF * g.ldb * 2;
    const size_t tstepA = 2 * hstepA, tstepB = 2 * hstepB;
    const unsigned ldsw = (unsigned)wid * 1024u;
    const int aoff = lds_byte(wr * 64 + fr, fq * 8), boff = lds_byte(wc * 32 + fr, fq * 8);
#define PG8_SA(b, h) (((b) * 2 + (h)) * HTB)
#define PG8_SB(b, h) ((4 + (b) * 2 + (h)) * HTB)
#define PG8_STAGE(bufoff, gbase, voff) do { _Pragma("unroll") for (int _i = 0; _i < 2; ++_i) \
        __builtin_amdgcn_global_load_lds((const unsigned*)((const char*)(gbase) + (voff)[_i]), (LAS unsigned*)(lds + (bufoff) + ldsw + _i * 8192), 16, 0, 0); } while (0)
#define PG8_LDA(dst, b, h) do { _Pragma("unroll") for (int m = 0; m < 4; ++m) _Pragma("unroll") for (int k = 0; k < 2; ++k) dst[m][k] = *(const LAS half8*)(lds + PG8_SA(b, h) + aoff + m * 2048 + k * 1024); } while (0)
#define PG8_LDB(dst, b, h) do { _Pragma("unroll") for (int n = 0; n < 2; ++n) _Pragma("unroll") for (int k = 0; k < 2; ++k) dst[n][k] = *(const LAS half8*)(lds + PG8_SB(b, h) + boff + n * 2048 + k * 1024); } while (0)
#define PG8_MMA(ai, bj, At, Bt) do { __builtin_amdgcn_s_setprio(1); _Pragma("unroll") for (int m = 0; m < 4; ++m) _Pragma("unroll") for (int n = 0; n < 2; ++n) _Pragma("unroll") for (int k = 0; k < 2; ++k) \
        acc[ai][bj][m][n] = __builtin_amdgcn_mfma_f32_16x16x32_f16(Bt[n][k], At[m][k], acc[ai][bj][m][n], 0, 0, 0); __builtin_amdgcn_s_setprio(0); } while (0)
#define PG8_WAIT_V(n) asm volatile("s_waitcnt vmcnt(" #n ")" ::: "memory")
#define PG8_WAIT_L(n) asm volatile("s_waitcnt lgkmcnt(" #n ")" ::: "memory")
#define PG8_BAR __builtin_amdgcn_s_barrier()
#define PG8_SCHED __builtin_amdgcn_sched_barrier(0)
#define PG8_ZERO() do { _Pragma("unroll") for (int a = 0; a < 2; ++a) _Pragma("unroll") for (int b = 0; b < 2; ++b) _Pragma("unroll") for (int m = 0; m < 4; ++m) _Pragma("unroll") for (int n = 0; n < 2; ++n) acc[a][b][m][n] = (f32x4){0.f, 0.f, 0.f, 0.f}; } while (0)
    Unit cur, nxt; int ui = 0;
    if (!S.next(0, cur)) return;
    f32x4 acc[2][2][4][2];
    PG8_ZERO();
    half8 At[4][2], B0[2][2], B1[2][2];
    const char* cA = (const char*)g.A + (size_t)cur.pm * tstepA + (size_t)cur.ka * 2; const char* cB = (const char*)g.Bt + (size_t)cur.pn * tstepB + (size_t)cur.kb * 2;
    PG8_STAGE(PG8_SB(0, 0), cB, voffB); PG8_STAGE(PG8_SB(0, 1), cB + hstepB, voffB); PG8_STAGE(PG8_SA(0, 0), cA, voffA); PG8_STAGE(PG8_SA(0, 1), cA + hstepA, voffA);
    if (wr == 1) PG8_BAR;
    PG8_WAIT_V(2); PG8_BAR;
    PG8_STAGE(PG8_SB(1, 0), cB + kstep, voffB); PG8_STAGE(PG8_SA(1, 0), cA + kstep, voffA); PG8_STAGE(PG8_SB(1, 1), cB + hstepB + kstep, voffB);
    PG8_WAIT_V(6); PG8_BAR;
    for (;;) {
        const bool has_next = S.next(ui + 1, nxt);
        const char* nA = has_next ? (const char*)g.A + (size_t)nxt.pm * tstepA + (size_t)nxt.ka * 2 : cA; const char* nB = has_next ? (const char*)g.Bt + (size_t)nxt.pn * tstepB + (size_t)nxt.kb * 2 : cB;
        for (int t = 0; t < nt; t += 2) {
            const bool last = (t == nt - 2);
            const char* a1 = cA + (size_t)(t + 1) * kstep;
            const char* a2 = last ? nA : cA + (size_t)(t + 2) * kstep; const char* b2 = last ? nB : cB + (size_t)(t + 2) * kstep;
            const char* a3 = a2 + kstep; const char* b3 = b2 + kstep;
            PG8_LDB(B0, 0, 0); PG8_LDB(B1, 0, 1); PG8_SCHED; PG8_LDA(At, 0, 0); PG8_STAGE(PG8_SA(1, 1), a1 + hstepA, voffA);
            PG8_WAIT_V(8); PG8_WAIT_L(0); PG8_BAR; PG8_MMA(0, 0, At, B0); PG8_MMA(0, 1, At, B1); PG8_BAR; PG8_SCHED;
            PG8_LDA(At, 0, 1); PG8_STAGE(PG8_SB(0, 0), b2, voffB); PG8_STAGE(PG8_SB(0, 1), b2 + hstepB, voffB); PG8_STAGE(PG8_SA(0, 0), a2, voffA);
            PG8_WAIT_V(8); PG8_WAIT_L(0); PG8_BAR; PG8_MMA(1, 0, At, B0); PG8_MMA(1, 1, At, B1); PG8_BAR; PG8_SCHED;
            PG8_LDB(B0, 1, 0); PG8_LDB(B1, 1, 1); PG8_SCHED; PG8_LDA(At, 1, 0); PG8_STAGE(PG8_SA(0, 1), a2 + hstepA, voffA);
            PG8_WAIT_V(8); PG8_WAIT_L(0); PG8_BAR; PG8_MMA(0, 0, At, B0); PG8_MMA(0, 1, At, B1); PG8_BAR; PG8_SCHED;
            PG8_LDA(At, 1, 1); PG8_STAGE(PG8_SB(1, 0), b3, voffB); PG8_STAGE(PG8_SB(1, 1), b3 + hstepB, voffB); PG8_STAGE(PG8_SA(1, 0), a3, voffA);
            PG8_WAIT_V(8); PG8_WAIT_L(0); PG8_BAR; PG8_MMA(1, 0, At, B0); PG8_MMA(1, 1, At, B1); PG8_BAR; PG8_SCHED;
        }
        if constexpr (ALIGN_EPI) { if (wr == 0) PG8_BAR; }
        E(acc, cur, wr, wc, fr, fq);
        if (!has_next) break;
        if (E.zero_after(cur)) PG8_ZERO();
        cur = nxt; cA = nA; cB = nB; ++ui;
        if constexpr (ALIGN_EPI) { if (wr == 1) PG8_BAR; }
    }
    PG8_WAIT_V(0);
    if constexpr (!ALIGN_EPI) { if (wr == 0) PG8_BAR; }
    PG8_BAR;
#undef PG8_SA
#undef PG8_SB
#undef PG8_STAGE
#undef PG8_LDA
#undef PG8_LDB
#undef PG8_MMA
#undef PG8_WAIT_V
#undef PG8_WAIT_L
#undef PG8_BAR
#undef PG8_SCHED
#undef PG8_ZERO
}
}
#define MK_N_LAUNCHES 1

constexpr int DM = 1024, NB = 4, SEQ = 4096, DECB = 32, DECS = 4, PAST = 8192, PAGE = 128, NPAGES = PAST / PAGE;
constexpr int MP = NB * SEQ, MS = DECB * DECS, MR = MP + MS, MT = 16640;
constexpr int HD = 64, IN_W = 4936, NIN = 5120, DFF = 2816, NGU = 2 * DFF, TOPK = 256;
constexpr int NKS = PAST + DECS;
constexpr float RMS_EPS = 1e-6f;
constexpr int NROPE = SEQ + DECS;
constexpr size_t O_Y_P = 0, O_Y_S = O_Y_P + (size_t)MP * DM, O_KVA_P = O_Y_S + (size_t)MS * DM, O_KI_P = O_KVA_P + (size_t)MP * 256, O_KVB_P = O_KI_P + (size_t)MP * 64,
                 O_KVA_S = O_KVB_P + (size_t)MP * 1024, O_KI_S = O_KVA_S + (size_t)MS * 256, O_KVB_S = O_KI_S + (size_t)MS * 64, O_END = O_KVB_S + (size_t)MS * 1024;
static_assert(O_END == 39100416, "d_out size");

constexpr size_t MiB = 1u << 20;
constexpr size_t al(size_t x) { return (x + MiB - 1) / MiB * MiB; }
constexpr size_t WS_CTL = 0, CTL_ZERO_BYTES = 1 * MiB;
constexpr size_t WS_WIN = 2 * MiB;
constexpr size_t WS_WBR = WS_WIN + al((size_t)NIN * DM * 2);
constexpr size_t WS_WO = WS_WBR + al((size_t)DM * DM * 2);
constexpr size_t WS_WGU = WS_WO + al((size_t)DM * DM * 2);
constexpr size_t WS_WDN = WS_WGU + al((size_t)NGU * DM * 2);
constexpr size_t WS_ROPE = WS_WDN + al((size_t)DM * DFF * 2);
constexpr size_t WS_RSTD1 = WS_ROPE + al((size_t)NROPE * 32 * 8);
constexpr size_t WS_SS2 = WS_RSTD1 + al((size_t)MT * 4);
constexpr size_t WS_SS3 = WS_SS2 + al((size_t)MT * 16 * 4);
constexpr size_t WS_XH = WS_SS3 + al((size_t)MT * 16 * 4);
constexpr size_t WS_QA = WS_XH + al((size_t)MT * DM * 2);
constexpr size_t WS_KA = WS_QA + al((size_t)MT * 512 * 2);
constexpr size_t WS_VA = WS_KA + al((size_t)MT * 128 * 2);
constexpr size_t WS_QI = WS_VA + al((size_t)MT * 128 * 2);
constexpr size_t WS_KI = WS_QI + al((size_t)MT * 512 * 2);
constexpr size_t WS_WI = WS_KI + al((size_t)MT * 64 * 2);
constexpr size_t WS_QB = WS_WI + al((size_t)MT * 8 * 4);
constexpr size_t WS_KB = WS_QB + al((size_t)MT * 512 * 2);
constexpr size_t WS_VB = WS_KB + al((size_t)MT * 512 * 2);
constexpr size_t WS_G = WS_VB + al((size_t)MT * 512 * 2);
constexpr size_t WS_OAB = WS_G + al((size_t)MT * 2048 * 2);
constexpr size_t WS_MG = WS_OAB + al((size_t)MT * DM * 2);
constexpr size_t WS_H = WS_MG + al((size_t)MT * DM * 2);
constexpr size_t WS_HH = WS_H + al((size_t)MT * DM * 4);
constexpr size_t WS_ACT = WS_HH + al((size_t)MT * DM * 2);
constexpr size_t WS_END = WS_ACT + al((size_t)MT * DFF * 2);
constexpr int CW_QUEUE = 64;
constexpr int CW_BAR = 4096;

constexpr int RING_BYTES = 131072;
constexpr int LDS_BYTES = 163840;
constexpr int MISC_OFF = LDS_BYTES - 256;
constexpr int NWAVES = 8;

#define RLX_AGENT __ATOMIC_RELAXED, __HIP_MEMORY_SCOPE_AGENT
#define LDS_WAIT() asm volatile("s_waitcnt lgkmcnt(0)" ::: "memory")
#define VM_WAIT() asm volatile("s_waitcnt vmcnt(0)" ::: "memory")

#define XB_TMO      128
#define XB_XCNT(j)  (256  + 64 * (j))
#define XB_XSUB(j)  (1280 + 64 * (j))
#define XB_XGEN(j)  (2304 + 64 * (j))
#define XB_TOP      3328
#define XB_TOPGEN   3392
#define XCD_BAR_WORDS 3456
#define XB_SPIN_CAP (1u << 18)

__device__ __forceinline__ unsigned xb_ld(unsigned* p)              { return __hip_atomic_load(p, __ATOMIC_RELAXED, __HIP_MEMORY_SCOPE_AGENT); }
__device__ __forceinline__ unsigned xb_add(unsigned* p, unsigned v) { return __hip_atomic_fetch_add(p, v, __ATOMIC_RELAXED, __HIP_MEMORY_SCOPE_AGENT); }
__device__ __forceinline__ unsigned xb_xcc_id() { return (unsigned)__builtin_amdgcn_s_getreg((3 << 11) | 20) & 0xFu; }
#define XB_SPIN(cond, bar) do { unsigned _sp = 0; while (cond) { __builtin_amdgcn_s_sleep(1); \
    if ((++_sp & 255u) == 0u) { if (xb_ld(&(bar)[XB_TMO])) break; if (_sp > XB_SPIN_CAP) { atomicAdd(&(bar)[XB_TMO], 1u); break; } } } } while (0)

struct XcdBarrier { unsigned* bar; unsigned x; volatile LAS unsigned* st; };

__device__ __forceinline__ XcdBarrier xcd_barrier_post(unsigned* bar, volatile LAS unsigned* st) {
    XcdBarrier b; b.bar = bar; b.x = xb_xcc_id(); b.st = st;
    if (threadIdx.x == 0) (void)xb_add(&bar[XB_XCNT(b.x)], 1u);
    return b;
}
__device__ __forceinline__ void xcd_barrier_complete(unsigned* bar, unsigned x, unsigned& nloc, unsigned& nx) {
    const unsigned G = gridDim.x * gridDim.y * gridDim.z;
    unsigned sum, cnt, mine, sp = 0u;
    for (;;) {
        sum = 0u; cnt = 0u; mine = 0u;
#pragma unroll
        for (unsigned j = 0; j < 16; ++j) { const unsigned c = xb_ld(&bar[XB_XCNT(j)]); sum += c; cnt += (c > 0u) ? 1u : 0u; mine = (j == x) ? c : mine; }
        if (sum == G) break;
        __builtin_amdgcn_s_sleep(1);
        if ((++sp & 255u) == 0u) { if (xb_ld(&bar[XB_TMO])) break; if (sp > XB_SPIN_CAP) { atomicAdd(&bar[XB_TMO], 1u); break; } }
    }
    nloc = mine > 0u ? mine : 1u; nx = cnt > 0u ? cnt : 1u;
}
__device__ __forceinline__ void xcd_barrier(const XcdBarrier& b) {
    asm volatile("s_waitcnt vmcnt(0)" ::: "memory");
    __syncthreads();
    if (threadIdx.x == 0) {
        unsigned* bar = b.bar;
        __builtin_amdgcn_s_waitcnt(0);
        unsigned nloc = b.st[0], nx = b.st[1];
        if (nloc == 0u) { xcd_barrier_complete(bar, b.x, nloc, nx); b.st[0] = nloc; b.st[1] = nx; }
        const unsigned old = xb_add(&bar[XB_XSUB(b.x)], 1u);
        const unsigned gen = old / nloc;
        if (old + 1u == (gen + 1u) * nloc) {
            __builtin_amdgcn_fence(__ATOMIC_RELEASE, "agent");
            asm volatile("s_waitcnt vmcnt(0)" ::: "memory");
            const unsigned og = xb_add(&bar[XB_TOP], 1u);
            const unsigned tg = og / nx;
            if (og + 1u == (tg + 1u) * nx) xb_add(&bar[XB_TOPGEN], 1u);
            else XB_SPIN(xb_ld(&bar[XB_TOPGEN]) == tg, bar);
            __builtin_amdgcn_fence(__ATOMIC_ACQUIRE, "agent");
            xb_add(&bar[XB_XGEN(b.x)], 1u);
            asm volatile("s_waitcnt vmcnt(0)" ::: "memory");
        } else {
            XB_SPIN(xb_ld(&bar[XB_XGEN(b.x)]) == gen, bar);
            __builtin_amdgcn_fence(__ATOMIC_ACQUIRE, "agent");
            asm volatile("s_waitcnt vmcnt(0)" ::: "memory");
        }
    }
    __syncthreads();
}

struct Params {
    const float *x_p, *x_s, *c_kva, *c_ki, *c_kvb; const int* pt;
    const float *w_in, *w_bra, *w_brb, *w_o, *g_attn, *g_ffn, *w_gate, *w_up, *w_down, *g_final;
    float* out; unsigned char* ws;
    int ph_lo, ph_hi;
};
struct Frame {
    LAS unsigned char* lds; volatile LAS unsigned* MISC; unsigned* ctl;
    int tid, lane, wave, G, bx;
};
__device__ __forceinline__ float wave_sum(float v) {
#pragma unroll
    for (int o = 1; o < 64; o <<= 1) v += __shfl_xor(v, o);
    return v;
}
__device__ __forceinline__ unsigned pkh(float lo, float hi) { half2v h = {(f16)lo, (f16)hi}; return __builtin_bit_cast(unsigned, h); }
__device__ __forceinline__ u32x4 pk8(const float* v) { u32x4 w; w.x = pkh(v[0], v[1]); w.y = pkh(v[2], v[3]); w.z = pkh(v[4], v[5]); w.w = pkh(v[6], v[7]); return w; }
__host__ __device__ __forceinline__ int in_col(int hs, int d) { return hs < 21 ? hs * 64 + d : (hs == 21 ? 1344 + d : 1352 + (hs - 22) * 64 + d); }

__device__ __forceinline__ void tr_item(const float* __restrict__ W, int ldw, int k0, int L0, int nvalid, const float* __restrict__ scale, f16* dst, int lddst, LAS float* scr, int lane) {
#pragma unroll 8
    for (int i = 0; i < 32; ++i) { const int kk = 2 * i + (lane >> 5), c = lane & 31; float v = 0.f;
        if (c < nvalid) { v = W[(size_t)(k0 + kk) * ldw + L0 + c]; if (scale) v *= scale[k0 + kk]; }
        scr[kk * 33 + c] = v; }
    LDS_WAIT(); asm volatile("" ::: "memory");
    const int c8 = lane & 7;
#pragma unroll
    for (int j = 0; j < 4; ++j) { const int n = (lane >> 3) + 8 * j; const LAS float* s = scr + (8 * c8) * 33 + n;
        u32x4 o; o.x = pkh(s[0 * 33], s[1 * 33]); o.y = pkh(s[2 * 33], s[3 * 33]); o.z = pkh(s[4 * 33], s[5 * 33]); o.w = pkh(s[6 * 33], s[7 * 33]);
        *(u32x4*)(dst + (size_t)n * lddst + 8 * c8) = o; }
    LDS_WAIT(); asm volatile("" ::: "memory");
}

__device__ __forceinline__ void p0_prologue(const Frame& F, const Params& P) {
    unsigned char* ws = P.ws;
    LAS float* scr = (LAS float*)(F.lds + F.wave * 16384);
    const int gw = F.bx * NWAVES + F.wave, NGW = F.G * NWAVES;
    constexpr int I_IN = 16 * (NIN / 32), I_BR = 8 * 32, I_O = 16 * 32, I_GU = 16 * (NGU / 32), I_DN = (DFF / 64) * 32;
    constexpr int NITEMS = I_IN + 2 * I_BR + I_O + I_GU + I_DN;
    for (int it = gw; it < NITEMS; it += NGW) {
        int r = it;
        if (r < I_IN) { const int nb = r % (NIN / 32), kb = r / (NIN / 32), n0 = 32 * nb, pn = n0 >> 8, bj = (n0 >> 7) & 1, wc = (n0 >> 5) & 3, hs = 4 * pn + wc;
            const int nvalid = hs == 21 ? (bj == 0 ? 8 : 0) : (hs < 78 ? 32 : 0);
            tr_item(P.w_in, IN_W, 64 * kb, in_col(hs < 78 ? hs : 0, 32 * bj), nvalid, P.g_attn, (f16*)(ws + WS_WIN) + (size_t)n0 * DM + 64 * kb, DM, scr, F.lane); continue; }
        r -= I_IN;
        if (r < I_BR) { const int nb = r % 32, kb = r / 32; tr_item(P.w_bra, DM, 64 * kb, 32 * nb, 32, nullptr, (f16*)(ws + WS_WBR) + (size_t)(32 * nb) * DM + 64 * kb, DM, scr, F.lane); continue; }
        r -= I_BR;
        if (r < I_BR) { const int nb = r % 32, kb = r / 32; tr_item(P.w_brb, DM, 64 * kb, 32 * nb, 32, nullptr, (f16*)(ws + WS_WBR) + (size_t)(32 * nb) * DM + 512 + 64 * kb, DM, scr, F.lane); continue; }
        r -= I_BR;
        if (r < I_O) { const int nb = r % 32, kb = r / 32; tr_item(P.w_o, DM, 64 * kb, 32 * nb, 32, nullptr, (f16*)(ws + WS_WO) + (size_t)(32 * nb) * DM + 64 * kb, DM, scr, F.lane); continue; }
        r -= I_O;
        if (r < I_GU) { const int nb = r % (NGU / 32), kb = r / (NGU / 32), n0 = 32 * nb, pn = n0 >> 8, bj = (n0 >> 7) & 1, j0 = n0 & 127;
            tr_item(bj ? P.w_up : P.w_gate, DFF, 64 * kb, 128 * pn + j0, 32, P.g_ffn, (f16*)(ws + WS_WGU) + (size_t)n0 * DM + 64 * kb, DM, scr, F.lane); continue; }
        r -= I_GU;
        { const int nb = r % 32, kb = r / 32; tr_item(P.w_down, DM, 64 * kb, 32 * nb, 32, nullptr, (f16*)(ws + WS_WDN) + (size_t)(32 * nb) * DFF + 64 * kb, DFF, scr, F.lane); }
    }
    float* rstd1 = (float*)(ws + WS_RSTD1);
    for (int m = gw; m < MT; m += NGW) {
        u32x2* o8 = (u32x2*)((f16*)(ws + WS_XH) + (size_t)m * DM) + F.lane;
        if (m < MR) {
            const float* xrow = m < MP ? P.x_p + (size_t)m * DM : P.x_s + (size_t)(m - MP) * DM;
            const f32x4* xr = (const f32x4*)xrow + F.lane;
            f32x4 v[4]; float s = 0.f;
#pragma unroll
            for (int j = 0; j < 4; ++j) { v[j] = xr[64 * j]; s += (v[j].x * v[j].x + v[j].y * v[j].y) + (v[j].z * v[j].z + v[j].w * v[j].w); }
            s = wave_sum(s);
            if (F.lane == 0) rstd1[m] = 1.0f / sqrtf(s * (1.0f / DM) + RMS_EPS);
#pragma unroll
            for (int j = 0; j < 4; ++j) o8[64 * j] = (u32x2){pkh(v[j].x, v[j].y), pkh(v[j].z, v[j].w)};
        } else {
            if (F.lane == 0) rstd1[m] = 0.f;
#pragma unroll
            for (int j = 0; j < 4; ++j) o8[64 * j] = (u32x2){0u, 0u};
        }
    }
    f32x2* rope = (f32x2*)(ws + WS_ROPE);
    for (int e = F.bx * (NWAVES * 64) + F.tid; e < NROPE * 32; e += F.G * NWAVES * 64) {
        const int p = e >> 5, i = e & 31, pos = p < SEQ ? p : PAST + (p - SEQ);
        const float inv = (float)exp2(-(double)i * (13.287712379549449 / 32.0));
        const float ang = (float)pos * inv;
        const double a = (double)ang, n = rint(a * 0.15915494309189535);
        double r = fma(-n, 6.283185307179586, a); r = fma(-n, 2.4492935982947064e-16, r);
        rope[e] = (f32x2){cosf((float)r), sinf((float)r)};
    }
}
__device__ __forceinline__ void ld8(const f32x4 (&a)[2], float* v) { v[0] = a[0][0]; v[1] = a[0][1]; v[2] = a[0][2]; v[3] = a[0][3]; v[4] = a[1][0]; v[5] = a[1][1]; v[6] = a[1][2]; v[7] = a[1][3]; }
__device__ __forceinline__ void st8f(float* p, const float* v) { *(f32x4*)p = (f32x4){v[0], v[1], v[2], v[3]}; *(f32x4*)(p + 4) = (f32x4){v[4], v[5], v[6], v[7]}; }
__device__ __forceinline__ void st8h(f16* p, const float* v) { *(u32x4*)p = pk8(v); }
__device__ __forceinline__ void ld8h(const f16* p, float* v) { const half8 h = *(const half8*)p;
#pragma unroll
    for (int i = 0; i < 8; ++i) v[i] = (float)h[i]; }
#define EPI_CALL_ROWS() _Pragma("unroll") for (int ai = 0; ai < 2; ++ai) _Pragma("unroll") for (int m = 0; m < 4; ++m) row_op(acc[ai][0][m], acc[ai][1][m], u.pm * 256 + ai * 128 + wr * 64 + m * 16 + fr, u, wc, fq)

struct EpiInProj {
    const float* rstd; const f32x2* rope; float* out; unsigned char* ws;
    __device__ __forceinline__ bool zero_after(const pg8::Unit&) const { return true; }
    __device__ __forceinline__ void row_op(f32x4 (&a0)[2], f32x4 (&a1)[2], int row, const pg8::Unit& u, int wc, int fq) const {
        const int hs = 4 * u.pn + wc, d0 = 8 * fq;
        if (hs >= 78 || row >= MR) return;
        bool do_rope = false; int func = 0  ;
        size_t o32p = 0, o32s = 0; int p32 = 0; bool has32 = false;
        f16* o16 = nullptr; int p16 = 0;
        if (hs < 8)        { do_rope = true; o16 = (f16*)(ws + WS_QA) + hs * 64; p16 = 512; }
        else if (hs < 10)  { do_rope = true; o16 = (f16*)(ws + WS_KA) + (hs - 8) * 64; p16 = 128; has32 = true; o32p = O_KVA_P + (hs - 8) * 64; o32s = O_KVA_S + (hs - 8) * 64; p32 = 256; }
        else if (hs < 12)  { o16 = (f16*)(ws + WS_VA) + (hs - 10) * 64; p16 = 128; has32 = true; o32p = O_KVA_P + 128 + (hs - 10) * 64; o32s = O_KVA_S + 128 + (hs - 10) * 64; p32 = 256; }
        else if (hs < 20)  { do_rope = true; o16 = (f16*)(ws + WS_QI) + (hs - 12) * 64; p16 = 512; }
        else if (hs == 20) { do_rope = true; o16 = (f16*)(ws + WS_KI); p16 = 64; has32 = true; o32p = O_KI_P; o32s = O_KI_S; p32 = 64; }
        else if (hs == 21) { func = 2; }
        else if (hs < 30)  { o16 = (f16*)(ws + WS_QB) + (hs - 22) * 64; p16 = 512; }
        else if (hs < 38)  { o16 = (f16*)(ws + WS_KB) + (hs - 30) * 64; p16 = 512; has32 = true; o32p = O_KVB_P + (hs - 30) * 64; o32s = O_KVB_S + (hs - 30) * 64; p32 = 1024; }
        else if (hs < 46)  { o16 = (f16*)(ws + WS_VB) + (hs - 38) * 64; p16 = 512; has32 = true; o32p = O_KVB_P + 512 + (hs - 38) * 64; o32s = O_KVB_S + 512 + (hs - 38) * 64; p32 = 1024; }
        else               { func = 1; o16 = (f16*)(ws + WS_G) + (hs - 46) * 64; p16 = 2048; }
        const float rs = rstd[row];
        float v1[8], v2[8]; ld8(a0, v1); ld8(a1, v2);
#pragma unroll
        for (int i = 0; i < 8; ++i) { v1[i] *= rs; v2[i] *= rs; }
        if (func == 2) { if (fq == 0) { float* w = (float*)(ws + WS_WI) + (size_t)row * 8;
#pragma unroll
            for (int i = 0; i < 8; ++i) v1[i] *= 0.35355339059327373f; st8f(w, v1); } return; }
        if (do_rope) {
            const int pidx = row < MP ? (row & (SEQ - 1)) : SEQ + ((row - MP) & (DECS - 1));
            const f32x4* rp = (const f32x4*)(rope + (size_t)pidx * 32 + d0);
#pragma unroll
            for (int j = 0; j < 4; ++j) { const f32x4 cs = rp[j];
                const float x0 = v1[2 * j], y0 = v2[2 * j], x1 = v1[2 * j + 1], y1 = v2[2 * j + 1];
                v1[2 * j] = x0 * cs[0] - y0 * cs[1]; v2[2 * j] = y0 * cs[0] + x0 * cs[1];
                v1[2 * j + 1] = x1 * cs[2] - y1 * cs[3]; v2[2 * j + 1] = y1 * cs[2] + x1 * cs[3]; }
        }
        if (func == 1) {
#pragma unroll
            for (int i = 0; i < 8; ++i) { v1[i] = fmaxf(1.0f / (1.0f + __expf(-v1[i])), 6.0e-8f); v2[i] = fmaxf(1.0f / (1.0f + __expf(-v2[i])), 6.0e-8f); }
        }
        if (has32) { float* o = out + (row < MP ? o32p + (size_t)row * p32 : o32s + (size_t)(row - MP) * p32) + d0; st8f(o, v1); st8f(o + 32, v2); }
        f16* oh = o16 + (size_t)row * p16 + d0; st8h(oh, v1); st8h(oh + 32, v2);
    }
    __device__ __forceinline__ void operator()(f32x4 (&acc)[2][2][4][2], const pg8::Unit& u, int wr, int wc, int fr, int fq) const { EPI_CALL_ROWS(); }
};

struct EpiBranch {
    const f16* G; f16* MG;
    __device__ __forceinline__ bool zero_after(const pg8::Unit& u) const { return u.sub != 0; }
    __device__ __forceinline__ void row_op(f32x4 (&a0)[2], f32x4 (&a1)[2], int row, const pg8::Unit& u, int wc, int fq) const {
        if (row >= MR) return;
#pragma unroll
        for (int bj = 0; bj < 2; ++bj) { const int col = u.pn * 256 + bj * 128 + wc * 32 + 8 * fq; f32x4 (&a)[2] = bj ? a1 : a0;
            float g1[8]; ld8h(G + (size_t)row * 2048 + 1024 + col, g1);
            if (u.sub == 0) { float g0[8]; ld8h(G + (size_t)row * 2048 + col, g0);
#pragma unroll
                for (int i = 0; i < 8; ++i) a[i >> 2][i & 3] *= g0[i] / g1[i];
            } else { float v[8]; ld8(a, v);
#pragma unroll
                for (int i = 0; i < 8; ++i) v[i] *= g1[i];
                st8h(MG + (size_t)row * DM + col, v); }
        }
    }
    __device__ __forceinline__ void operator()(f32x4 (&acc)[2][2][4][2], const pg8::Unit& u, int wr, int wc, int fr, int fq) const { EPI_CALL_ROWS(); }
};

struct EpiWo {
    const float *x_p, *x_s; float* H; f16* HH; float* SS;
    __device__ __forceinline__ bool zero_after(const pg8::Unit&) const { return true; }
    __device__ __forceinline__ void row_op(f32x4 (&a0)[2], f32x4 (&a1)[2], int row, const pg8::Unit& u, int wc, int fq) const {
        float ss = 0.f;
        if (row < MR) { const float* xr = row < MP ? x_p + (size_t)row * DM : x_s + (size_t)(row - MP) * DM;
#pragma unroll
            for (int bj = 0; bj < 2; ++bj) { const int col = u.pn * 256 + bj * 128 + wc * 32 + 8 * fq;
                float v[8]; ld8(bj ? a1 : a0, v); const f32x4 x0 = *(const f32x4*)(xr + col), x1 = *(const f32x4*)(xr + col + 4);
#pragma unroll
                for (int i = 0; i < 4; ++i) { v[i] += x0[i]; v[4 + i] += x1[i]; }
#pragma unroll
                for (int i = 0; i < 8; ++i) ss += v[i] * v[i];
                st8f(H + (size_t)row * DM + col, v); st8h(HH + (size_t)row * DM + col, v); } }
        ss += __shfl_xor(ss, 16); ss += __shfl_xor(ss, 32);
        if (fq == 0 && row < MR) SS[(size_t)row * 16 + u.pn * 4 + wc] = ss;
    }
    __device__ __forceinline__ void operator()(f32x4 (&acc)[2][2][4][2], const pg8::Unit& u, int wr, int wc, int fr, int fq) const { EPI_CALL_ROWS(); }
};

__device__ __forceinline__ float rstd_from_parts(const float* SS, int row) {
    const f32x4* p = (const f32x4*)(SS + (size_t)row * 16); const f32x4 a = p[0], b = p[1], c = p[2], d = p[3];
    const float s = ((a[0] + a[1]) + (a[2] + a[3])) + ((b[0] + b[1]) + (b[2] + b[3])) + ((c[0] + c[1]) + (c[2] + c[3])) + ((d[0] + d[1]) + (d[2] + d[3]));
    return 1.0f / sqrtf(s * (1.0f / DM) + RMS_EPS);
}

struct EpiGateUp {
    const float* SS; f16* ACT;
    __device__ __forceinline__ bool zero_after(const pg8::Unit&) const { return true; }
    __device__ __forceinline__ void row_op(f32x4 (&a0)[2], f32x4 (&a1)[2], int row, const pg8::Unit& u, int wc, int fq) const {
        if (row >= MR) return;
        const float rs = rstd_from_parts(SS, row);
        float g[8], up[8], a[8]; ld8(a0, g); ld8(a1, up);
#pragma unroll
        for (int i = 0; i < 8; ++i) { const float gg = g[i] * rs; a[i] = gg * (up[i] * rs) / (1.0f + __expf(-gg)); }
        st8h(ACT + (size_t)row * DFF + u.pn * 128 + wc * 32 + 8 * fq, a);
    }
    __device__ __forceinline__ void operator()(f32x4 (&acc)[2][2][4][2], const pg8::Unit& u, int wr, int wc, int fr, int fq) const { EPI_CALL_ROWS(); }
};

struct EpiDown {
    const float* H; float* out; float* SS;
    __device__ __forceinline__ bool zero_after(const pg8::Unit&) const { return true; }
    __device__ __forceinline__ void row_op(f32x4 (&a0)[2], f32x4 (&a1)[2], int row, const pg8::Unit& u, int wc, int fq) const {
        float ss = 0.f;
        if (row < MR) { float* yr = out + (row < MP ? O_Y_P + (size_t)row * DM : O_Y_S + (size_t)(row - MP) * DM);
#pragma unroll
            for (int bj = 0; bj < 2; ++bj) { const int col = u.pn * 256 + bj * 128 + wc * 32 + 8 * fq;
                float v[8]; ld8(bj ? a1 : a0, v); const f32x4 h0 = *(const f32x4*)(H + (size_t)row * DM + col), h1 = *(const f32x4*)(H + (size_t)row * DM + col + 4);
#pragma unroll
                for (int i = 0; i < 4; ++i) { v[i] += h0[i]; v[4 + i] += h1[i]; }
#pragma unroll
                for (int i = 0; i < 8; ++i) ss += v[i] * v[i];
                st8f(yr + col, v); } }
        ss += __shfl_xor(ss, 16); ss += __shfl_xor(ss, 32);
        if (fq == 0 && row < MR) SS[(size_t)row * 16 + u.pn * 4 + wc] = ss;
    }
    __device__ __forceinline__ void operator()(f32x4 (&acc)[2][2][4][2], const pg8::Unit& u, int wr, int wc, int fr, int fq) const { EPI_CALL_ROWS(); }
};

#define SG_STEP(K_) do { const half8 x_ = *(const half8*)(ap + (K_)); \
        const half8 w0_ = *(const half8*)(wp + (K_)), w1_ = *(const half8*)(wp + (size_t)4 * g.ldb + (K_)), w2_ = *(const half8*)(wp + (size_t)128 * g.ldb + (K_)), w3_ = *(const half8*)(wp + (size_t)132 * g.ldb + (K_)); \
        a[0] = __builtin_amdgcn_mfma_f32_16x16x32_f16(w0_, x_, a[0], 0, 0, 0); a[1] = __builtin_amdgcn_mfma_f32_16x16x32_f16(w1_, x_, a[1], 0, 0, 0); \
        a[2] = __builtin_amdgcn_mfma_f32_16x16x32_f16(w2_, x_, a[2], 0, 0, 0); a[3] = __builtin_amdgcn_mfma_f32_16x16x32_f16(w3_, x_, a[3], 0, 0, 0); } while (0)
template <class Epi> __device__ __forceinline__ void small_gemm_wg(LAS unsigned char* lds, const pg8::Gemm& g, const Epi& E, int tile0, int tstride, int ntiles, int nsub, int wave, int lane) {
    asm volatile("" : "+v"(lane));
    const int fr = lane & 15, fq = lane >> 4, kw = g.K / 8;
    LAS f32x4* red = (LAS f32x4*)lds;
#pragma unroll 1
    for (int t = tile0; t < ntiles; t += tstride) {
        const int m = t & 3, wc = (t >> 2) & 3, wr = (t >> 4) & 1, pn = t >> 5;
        const int row = MP + 64 * wr + 16 * m + fr;
        const f16* ap = g.A + (size_t)row * g.lda + 8 * fq;
        const f16* wp = g.Bt + (size_t)(256 * pn + 32 * wc + 8 * (fr >> 2) + (fr & 3)) * g.ldb + 8 * fq;
        pg8::Unit u; u.pm = MP / 256; u.pn = pn; u.ka = u.kb = 0; u.sub = 1;
        f32x4 tot0[2], tot1[2];
        tot0[0] = tot0[1] = tot1[0] = tot1[1] = (f32x4){0.f, 0.f, 0.f, 0.f};
#pragma unroll 1
        for (int sub = 0; sub < nsub; ++sub) {
            f32x4 a[4];
            a[0] = a[1] = a[2] = a[3] = (f32x4){0.f, 0.f, 0.f, 0.f};
            int k = sub * g.K + wave * kw; const int kend = k + kw;
#pragma unroll 1
            for (; k + 128 <= kend; k += 128) { SG_STEP(k); SG_STEP(k + 32); SG_STEP(k + 64); SG_STEP(k + 96); }
#pragma unroll 1
            for (; k < kend; k += 32) SG_STEP(k);
            if (wave > 0) {
#pragma unroll
                for (int i = 0; i < 4; ++i) red[((wave - 1) * 4 + i) * 64 + lane] = a[i]; }
            LDS_WAIT(); __syncthreads();
            if (wave == 0) {
#pragma unroll
                for (int w = 0; w < 7; ++w)
#pragma unroll
                    for (int i = 0; i < 4; ++i) a[i] += red[(w * 4 + i) * 64 + lane];
                tot0[0] += a[0]; tot0[1] += a[1]; tot1[0] += a[2]; tot1[1] += a[3];
                u.sub = nsub == 2 ? sub : 1;
                E.row_op(tot0, tot1, row, u, wc, fq);
            }
            __syncthreads();
        }
    }
}
#undef SG_STEP
constexpr int SCP_P = 8224, SCP_S = 16448, HIST_OFF = 131584, HIST_PITCH = 1040, IDXL_OFF = HIST_OFF + 16 * HIST_PITCH, IDXL_PITCH = 544, WBUF = 9216, VPITCH = 144;
static_assert(IDXL_OFF + 16 * IDXL_PITCH <= MISC_OFF && 8 * WBUF <= HIST_OFF && 16 * SCP_P <= HIST_OFF && 4 * SCP_S <= HIST_OFF, "attention LDS map");
constexpr float LOG2E = 1.4426950408889634f, LN2 = 0.6931471805599453f;

__device__ __forceinline__ f32x4 mfma16(half8 a, half8 b, f32x4 c) { return __builtin_amdgcn_mfma_f32_16x16x32_f16(a, b, c, 0, 0, 0); }
__device__ __forceinline__ f32x16 mfma32(half8 a, half8 b, f32x16 c) { return __builtin_amdgcn_mfma_f32_32x32x16_f16(a, b, c, 0, 0, 0); }
__device__ __forceinline__ half8 cvt8(f32x4 a, f32x4 b) { half8 h; h[0] = (f16)a[0]; h[1] = (f16)a[1]; h[2] = (f16)a[2]; h[3] = (f16)a[3]; h[4] = (f16)b[0]; h[5] = (f16)b[1]; h[6] = (f16)b[2]; h[7] = (f16)b[3]; return h; }
template <int OFF> __device__ __forceinline__ half4 tr_read(unsigned lds_addr) { s16x4 r; asm volatile("ds_read_b64_tr_b16 %0, %1 offset:%2\n\ts_waitcnt lgkmcnt(0)" : "=&v"(r) : "v"(lds_addr), "n"(OFF) : "memory"); return __builtin_bit_cast(half4, r); }
#define LAUNDER(x) asm volatile("" : "+v"(x))
template <int O0, int O1, int O2, int O3, int O4, int O5, int O6, int O7> __device__ __forceinline__ void tr_read8(unsigned a, half4 (&r)[8]) {
    s16x4 d0, d1, d2, d3, d4, d5, d6, d7;
    asm volatile("ds_read_b64_tr_b16 %0, %8 offset:%9\n\tds_read_b64_tr_b16 %1, %8 offset:%10\n\tds_read_b64_tr_b16 %2, %8 offset:%11\n\tds_read_b64_tr_b16 %3, %8 offset:%12\n\t"
                 "ds_read_b64_tr_b16 %4, %8 offset:%13\n\tds_read_b64_tr_b16 %5, %8 offset:%14\n\tds_read_b64_tr_b16 %6, %8 offset:%15\n\tds_read_b64_tr_b16 %7, %8 offset:%16\n\ts_waitcnt lgkmcnt(0)"
                 : "=&v"(d0), "=&v"(d1), "=&v"(d2), "=&v"(d3), "=&v"(d4), "=&v"(d5), "=&v"(d6), "=&v"(d7)
                 : "v"(a), "n"(O0), "n"(O1), "n"(O2), "n"(O3), "n"(O4), "n"(O5), "n"(O6), "n"(O7) : "memory");
    r[0] = __builtin_bit_cast(half4, d0); r[1] = __builtin_bit_cast(half4, d1); r[2] = __builtin_bit_cast(half4, d2); r[3] = __builtin_bit_cast(half4, d3);
    r[4] = __builtin_bit_cast(half4, d4); r[5] = __builtin_bit_cast(half4, d5); r[6] = __builtin_bit_cast(half4, d6); r[7] = __builtin_bit_cast(half4, d7);
}
__device__ __forceinline__ half8 cat4(half4 lo, half4 hi) { return __builtin_shufflevector(lo, hi, 0, 1, 2, 3, 4, 5, 6, 7); }
__device__ __forceinline__ unsigned lds_addr_of(LAS const void* p) { return (unsigned)(size_t)p; }
__device__ __forceinline__ unsigned tokey(unsigned h) { return (h & 0x8000u) ? (~h & 0xFFFFu) : (h | 0x8000u); }

__device__ __forceinline__ void find_bin(LAS unsigned* hist, unsigned need, int lane, unsigned& bin, unsigned& above) {
    const u32x4 c = *(LAS u32x4*)(hist + 4 * lane);
    const unsigned s = c.x + c.y + c.z + c.w; unsigned S = s;
#pragma unroll
    for (int off = 1; off < 64; off <<= 1) { const unsigned t = __shfl_down(S, off); if (lane + off < 64) S += t; }
    const unsigned ab = S - s;
    const unsigned long long mk = __ballot((ab < need) && (S >= need));
    const int L = mk ? __ffsll((long long)mk) - 1 : 0;
    unsigned cum = ab, b = 4 * lane, a = ab; bool found = false;
#pragma unroll
    for (int e = 3; e >= 0; --e) { const unsigned ce = c[e]; if (!found && cum + ce >= need) { b = 4 * lane + e; a = cum; found = true; } cum += ce; }
    bin = __shfl(b, L); above = __shfl(a, L);
}
__device__ __forceinline__ int topk_select(LAS const unsigned short* row, int n, LAS unsigned* hist, LAS unsigned short* idxo, int lane) {
    LAUNDER(lane);
    if (n <= TOPK) { for (int i = lane; i < n; i += 64) idxo[i] = (unsigned short)i; LDS_WAIT(); return n; }
    unsigned B1 = 0, ab1 = 0, B2 = 0, ab2 = 0;
    find_bin(hist, (unsigned)TOPK, lane, B1, ab1);
    LDS_WAIT(); asm volatile("" ::: "memory");
    *(LAS u32x4*)(hist + 4 * lane) = (u32x4){0u, 0u, 0u, 0u};
    LDS_WAIT(); asm volatile("" ::: "memory");
#pragma unroll 1
    for (int base = 0; base < n; base += 512) { const int i0 = base + 8 * lane;
        if (i0 < n) { const u32x4 v = *(LAS const u32x4*)(row + i0);
#pragma unroll
            for (int e = 0; e < 8; ++e) { const unsigned k = tokey((v[e >> 1] >> (16 * (e & 1))) & 0xFFFFu);
                if ((i0 + e < n) && (k >> 8) == B1) __hip_atomic_fetch_add(hist + (k & 255u), 1u, __ATOMIC_RELAXED, __HIP_MEMORY_SCOPE_WORKGROUP); } } }
    LDS_WAIT(); asm volatile("" ::: "memory");
    find_bin(hist, (unsigned)TOPK - ab1, lane, B2, ab2);
    LDS_WAIT(); asm volatile("" ::: "memory");
    const unsigned T = (B1 << 8) | B2, r2 = (unsigned)TOPK - ab1 - ab2;
    int pos = 0; unsigned ties = 0;
#define WPREFIX(cnt, excl, total) do { unsigned e_ = 0, t_ = 0; _Pragma("unroll") for (int b_ = 0; b_ < 4; ++b_) { const unsigned long long m_ = __ballot(((cnt) >> b_) & 1u); \
        e_ += __builtin_amdgcn_mbcnt_hi((unsigned)(m_ >> 32), __builtin_amdgcn_mbcnt_lo((unsigned)m_, 0u)) << b_; t_ += (unsigned)__popcll(m_) << b_; } (excl) = e_; (total) = t_; } while (0)
#pragma unroll 1
    for (int base = 0; base < n; base += 512) { const int i0 = base + 8 * lane;
        u32x4 v = (u32x4){0u, 0u, 0u, 0u}; if (i0 < n) v = *(LAS const u32x4*)(row + i0);
        unsigned gtm = 0, eqm = 0;
#pragma unroll
        for (int e = 0; e < 8; ++e) { const unsigned k = tokey((v[e >> 1] >> (16 * (e & 1))) & 0xFFFFu); const bool in = i0 + e < n; gtm |= (in && k > T) ? (1u << e) : 0u; eqm |= (in && k == T) ? (1u << e) : 0u; }
        unsigned selm = gtm;
        if (__ballot(eqm != 0u)) { unsigned ex, tot; const unsigned ce = (unsigned)__popc(eqm); WPREFIX(ce, ex, tot);
            unsigned tb = ties + ex;
#pragma unroll
            for (int e = 0; e < 8; ++e) if ((eqm >> e) & 1u) { if (tb < r2) selm |= 1u << e; ++tb; }
            ties += tot; }
        unsigned ex, tot; const unsigned cs = (unsigned)__popc(selm); WPREFIX(cs, ex, tot);
        int p = pos + (int)ex;
#pragma unroll
        for (int e = 0; e < 8; ++e) if ((selm >> e) & 1u) { idxo[p] = (unsigned short)(i0 + e); ++p; }
        pos += (int)tot; }
#undef WPREFIX
    LDS_WAIT();
    return pos;
}

struct KvSrc {
    const f16 *KA, *VA; const float *cache, *newrows; const int* pt; int rowbase;
};
template <bool SAMPLE> struct KvFrag;
template <> struct KvFrag<false> {
    half8 v;
    __device__ __forceinline__ void load(const KvSrc& S, int key, int kv, int off) { v = *(const half8*)((kv ? S.VA : S.KA) + (size_t)(S.rowbase + key) * 128 + off); }
    __device__ __forceinline__ half8 get() const { return v; }
};
template <> struct KvFrag<true> {
    f32x4 a, b;
    __device__ __forceinline__ void load(const KvSrc& S, int key, int kv, int off) {
        const int kc = key < PAST ? key : PAST - 1;
        const float* p = (key < PAST ? S.cache + ((size_t)S.pt[kc >> 7] * PAGE + (kc & (PAGE - 1))) * 256 : S.newrows + (size_t)(key - PAST) * 256) + kv * 128 + off;
        a = *(const f32x4*)p; b = *(const f32x4*)(p + 4); }
    __device__ __forceinline__ half8 get() const { return cvt8(a, b); }
};
template <bool SAMPLE> __device__ __forceinline__ void dsa_pair(const KvSrc& S, LAS const unsigned short* idx, int cnt, const f16* QA, int qrow, int c, LAS unsigned char* vbuf, f16* OAB, int lane) {
    LAUNDER(lane);
    const int fr = lane & 15, fq = lane >> 4;
    half8 B0, B1;
#pragma unroll
    for (int i = 0; i < 8; ++i) { B0[i] = (f16)0.f; B1[i] = (f16)0.f; }
    if (fr < 4) { const f16* q = QA + (size_t)qrow * 512 + (4 * c + fr) * 64; B0 = *(const half8*)(q + 8 * fq); B1 = *(const half8*)(q + 32 + 8 * fq); }
    f32x4 s[16];
    constexpr int GBK = SAMPLE ? 4 : 16;
#pragma unroll
    for (int gb = 0; gb < 16; gb += GBK) {
        KvFrag<SAMPLE> A[GBK][2];
#pragma unroll
        for (int j = 0; j < GBK; ++j) { const int slot = 16 * (gb + j) + fr, key = idx[slot < cnt ? slot : cnt - 1];
            A[j][0].load(S, key, 0, c * 64 + 8 * fq); A[j][1].load(S, key, 0, c * 64 + 32 + 8 * fq); }
#pragma unroll
        for (int j = 0; j < GBK; ++j) { s[gb + j] = mfma16(A[j][0].get(), B0, (f32x4){0.f, 0.f, 0.f, 0.f}); s[gb + j] = mfma16(A[j][1].get(), B1, s[gb + j]); }
    }
    constexpr int NVB = SAMPLE ? 1 : 4;
    KvFrag<SAMPLE> Vr[NVB][8];
    if (!SAMPLE) {
#pragma unroll
        for (int ch = 0; ch < 4; ++ch)
#pragma unroll
            for (int i = 0; i < 8; ++i) { const int slot = 64 * ch + (lane >> 3) + 8 * i, key = idx[slot < cnt ? slot : cnt - 1]; Vr[ch % NVB][i].load(S, key, 1, c * 64 + 8 * (lane & 7)); }
        asm volatile("" ::: "memory");
    }
    float mx = -INFINITY;
#pragma unroll
    for (int g = 0; g < 16; ++g)
#pragma unroll
        for (int e = 0; e < 4; ++e) { const float v = (16 * g + 4 * fq + e < cnt) ? s[g][e] * (0.125f * LOG2E) : -INFINITY; s[g][e] = v; mx = fmaxf(mx, v); }
    mx = fmaxf(mx, __shfl_xor(mx, 16)); mx = fmaxf(mx, __shfl_xor(mx, 32));
    float l = 0.f;
#pragma unroll
    for (int g = 0; g < 16; ++g)
#pragma unroll
        for (int e = 0; e < 4; ++e) { const float p = __builtin_amdgcn_exp2f(s[g][e] - mx); s[g][e] = p; l += p; }
    l += __shfl_xor(l, 16); l += __shfl_xor(l, 32);
    f32x4 o[4];
#pragma unroll
    for (int dt = 0; dt < 4; ++dt) o[dt] = (f32x4){0.f, 0.f, 0.f, 0.f};
    const unsigned vb = lds_addr_of(vbuf) + (unsigned)((4 * fq + (fr >> 2)) * VPITCH + (fr & 3) * 8);
    LAS unsigned char* vw = vbuf + (lane >> 3) * VPITCH + (lane & 7) * 16;
#pragma unroll
    for (int ch = 0; ch < 4; ++ch) {
        if (SAMPLE) {
#pragma unroll
            for (int i = 0; i < 8; ++i) { const int slot = 64 * ch + (lane >> 3) + 8 * i, key = idx[slot < cnt ? slot : cnt - 1]; Vr[0][i].load(S, key, 1, c * 64 + 8 * (lane & 7)); }
        }
#pragma unroll
        for (int i = 0; i < 8; ++i) *(LAS half8*)(vw + 8 * i * VPITCH) = Vr[ch % NVB][i].get();
        LDS_WAIT(); asm volatile("" ::: "memory");
#pragma unroll
        for (int ksl = 0; ksl < 2; ++ksl) { const int ks = 2 * ch + ksl;
            half8 pf;
#pragma unroll
            for (int j = 0; j < 4; ++j) { pf[j] = (f16)s[2 * ks][j]; pf[4 + j] = (f16)s[2 * ks + 1][j]; }
            half4 t[8];
            if (ksl) tr_read8<32 * VPITCH, 48 * VPITCH, 32 * VPITCH + 32, 48 * VPITCH + 32, 32 * VPITCH + 64, 48 * VPITCH + 64, 32 * VPITCH + 96, 48 * VPITCH + 96>(vb, t);
            else     tr_read8<0, 16 * VPITCH, 32, 16 * VPITCH + 32, 64, 16 * VPITCH + 64, 96, 16 * VPITCH + 96>(vb, t);
#pragma unroll
            for (int dt = 0; dt < 4; ++dt) o[dt] = mfma16(cat4(t[2 * dt], t[2 * dt + 1]), pf, o[dt]);
        }
        asm volatile("" ::: "memory");
    }
    if (fr < 4) { const float il = 1.0f / l; f16* op = OAB + (size_t)qrow * 1024 + (4 * c + fr) * 64 + 4 * fq;
#pragma unroll
        for (int dt = 0; dt < 4; ++dt) *(u32x2*)(op + 16 * dt) = (u32x2){pkh(o[dt][0] * il, o[dt][1] * il), pkh(o[dt][2] * il, o[dt][3] * il)}; }
}

template <bool SAMPLE> __device__ __forceinline__ void idx_unit(const Frame& F, const Params& P, int bs, int tt, int smask = 7) {
    unsigned char* ws = P.ws;
    int lane = F.lane; LAUNDER(lane);
    const int wave = F.wave, fr = lane & 15, fq = lane >> 4;
    const f16* QI = (const f16*)(ws + WS_QI); const f16* KI = (const f16*)(ws + WS_KI); const float* WI = (const float*)(ws + WS_WI);
    const int t0 = SAMPLE ? 0 : 16 * tt, rowbase = SAMPLE ? MP + 4 * bs : bs * SEQ;
    const int qrow_l = SAMPLE ? rowbase + (fr < 4 ? fr : 3) : rowbase + t0 + fr;
    constexpr int SCP = SAMPLE ? SCP_S : SCP_P;
    for (int i = F.tid; i < 16 * HIST_PITCH / 4; i += NWAVES * 64) ((LAS unsigned*)(F.lds + HIST_OFF))[i] = 0u;
    LDS_WAIT(); __syncthreads();
    {
        half8 Bq[8][2]; float w[8];
#pragma unroll
        for (int h = 0; h < 8; ++h) { const f16* q = QI + (size_t)qrow_l * 512 + h * 64; Bq[h][0] = *(const half8*)(q + 8 * fq); Bq[h][1] = *(const half8*)(q + 32 + 8 * fq); w[h] = WI[(size_t)qrow_l * 8 + h] * 0.125f; }
        const int ng = SAMPLE ? (PAST / 16 + 1) : tt + 1, nit = (ng + 4 * NWAVES - 1) / (4 * NWAVES);
        const int* pt = P.pt + bs * NPAGES;
        const float* newki = P.out + O_KI_S + (size_t)bs * (DECS * 64);
#pragma unroll 1
        for (int it = 0; it < nit; ++it) {
            const int g0 = 4 * (wave + NWAVES * it);
            half8 Ah[4][2]; f32x4 Af[4][4];
#pragma unroll
            for (int j = 0; j < 4; ++j) { const int g = (g0 + j < ng) ? g0 + j : ng - 1;
                if (SAMPLE) { const int key = 16 * g + fr, kc = key < PAST ? key : PAST - 1, kn = key - PAST;
                    const float* p = (key < PAST ? P.c_ki + ((size_t)pt[kc >> 7] * PAGE + (kc & (PAGE - 1))) * 64 : newki + (kn < DECS ? kn : DECS - 1) * 64) + 8 * fq;
                    Af[j][0] = *(const f32x4*)p; Af[j][1] = *(const f32x4*)(p + 4); Af[j][2] = *(const f32x4*)(p + 32); Af[j][3] = *(const f32x4*)(p + 36); }
                else { const f16* k = KI + (size_t)(rowbase + 16 * g + fr) * 64 + 8 * fq; Ah[j][0] = *(const half8*)k; Ah[j][1] = *(const half8*)(k + 32); } }
#pragma unroll
            for (int j = 0; j < 4; ++j) {
                const half8 A0 = SAMPLE ? cvt8(Af[j][0], Af[j][1]) : Ah[j][0], A1 = SAMPLE ? cvt8(Af[j][2], Af[j][3]) : Ah[j][1];
                f32x4 sc = (f32x4){0.f, 0.f, 0.f, 0.f};
#pragma unroll
                for (int h = 0; h < 8; ++h) { f32x4 sv = mfma16(A0, Bq[h][0], (f32x4){0.f, 0.f, 0.f, 0.f}); sv = mfma16(A1, Bq[h][1], sv);
#pragma unroll
                    for (int e = 0; e < 4; ++e) sc[e] = fmaf(w[h], fmaxf(sv[e], 0.f), sc[e]); }
                if (g0 + j < ng && (!SAMPLE || fr < 4)) { const unsigned w0 = pkh(sc[0], sc[1]), w1 = pkh(sc[2], sc[3]);
                    *(LAS u32x2*)(F.lds + fr * SCP + (16 * (g0 + j) + 4 * fq) * 2) = (u32x2){w0, w1};
                    const int kb = 16 * (g0 + j) + 4 * fq, qp = SAMPLE ? PAST + fr : t0 + fr;
                    LAS unsigned* hq = (LAS unsigned*)(F.lds + HIST_OFF + fr * HIST_PITCH);
                    if (kb + 0 <= qp) __hip_atomic_fetch_add(hq + (tokey(w0 & 0xFFFFu) >> 8), 1u, __ATOMIC_RELAXED, __HIP_MEMORY_SCOPE_WORKGROUP);
                    if (kb + 1 <= qp) __hip_atomic_fetch_add(hq + (tokey(w0 >> 16) >> 8), 1u, __ATOMIC_RELAXED, __HIP_MEMORY_SCOPE_WORKGROUP);
                    if (kb + 2 <= qp) __hip_atomic_fetch_add(hq + (tokey(w1 & 0xFFFFu) >> 8), 1u, __ATOMIC_RELAXED, __HIP_MEMORY_SCOPE_WORKGROUP);
                    if (kb + 3 <= qp) __hip_atomic_fetch_add(hq + (tokey(w1 >> 16) >> 8), 1u, __ATOMIC_RELAXED, __HIP_MEMORY_SCOPE_WORKGROUP); }
            }
        }
    }
    LDS_WAIT(); __syncthreads();
    if (!(smask & 2)) return;
#pragma unroll 1
    for (int qi = wave; qi < (SAMPLE ? 4 : 16); qi += NWAVES) {
        LAS unsigned short* io = (LAS unsigned short*)(F.lds + IDXL_OFF + qi * IDXL_PITCH);
        const int n = SAMPLE ? PAST + qi + 1 : t0 + qi + 1;
        const int cnt = topk_select((LAS const unsigned short*)(F.lds + qi * SCP), n, (LAS unsigned*)(F.lds + HIST_OFF + qi * HIST_PITCH), io, lane);
        if (lane == 0) io[256] = (unsigned short)cnt;
    }
    LDS_WAIT(); __syncthreads();
    if (!(smask & 4)) return;
    KvSrc S; S.KA = (const f16*)(ws + WS_KA); S.VA = (const f16*)(ws + WS_VA); S.cache = P.c_kva; S.newrows = P.out + O_KVA_S + (size_t)bs * (DECS * 256); S.pt = P.pt + bs * NPAGES; S.rowbase = rowbase;
#pragma unroll 1
    for (int p = wave; p < (SAMPLE ? 8 : 32); p += NWAVES) { const int qi = p >> 1, c = p & 1;
        LAS const unsigned short* io = (LAS const unsigned short*)(F.lds + IDXL_OFF + qi * IDXL_PITCH);
        const int cnt = io[256];
        dsa_pair<SAMPLE>(S, io, cnt, (const f16*)(ws + WS_QA), rowbase + t0 + qi, c, F.lds + wave * WBUF, (f16*)(ws + WS_OAB), lane);
    }
}

__device__ __forceinline__ int crow(int reg, int h) { return (reg & 3) + 8 * (reg >> 2) + 4 * h; }
template <bool SAMPLE> __device__ __forceinline__ void sb_item(const Params& P, int bs, int h, int qt, LAS unsigned char* buf, int lane) {
    unsigned char* ws = P.ws;
    const f16* QB = (const f16*)(ws + WS_QB); const f16* KB = (const f16*)(ws + WS_KB); const f16* VB = (const f16*)(ws + WS_VB);
    LAUNDER(lane);
    const int r = lane & 31, h2 = lane >> 5;
    const int qpos = SAMPLE ? PAST + (r < 4 ? r : 3) : 32 * qt + r;
    const int qrow = SAMPLE ? MP + 4 * bs + (r < 4 ? r : 3) : bs * SEQ + qpos;
    half8 Bq[4];
#pragma unroll
    for (int ks = 0; ks < 4; ++ks) Bq[ks] = *(const half8*)(QB + (size_t)qrow * 512 + h * 64 + 16 * ks + 8 * h2);
    f32x16 O0, O1;
#pragma unroll
    for (int i = 0; i < 16; ++i) { O0[i] = 0.f; O1[i] = 0.f; }
    float carry = 0.f;
    LAS unsigned char* kb = buf; LAS unsigned char* vbp = buf + 32 * VPITCH;
    const unsigned vb = lds_addr_of(vbp) + (unsigned)((4 * h2 + ((lane & 15) >> 2)) * VPITCH + (16 * ((lane >> 4) & 1) + 4 * (lane & 3)) * 2);
    const int* pt = P.pt + bs * NPAGES;
    half8 Kh[4], Vh[4]; f32x4 Kf[8], Vf[8];
    const float* newkvb = P.out + O_KVB_S + (size_t)bs * (DECS * 1024);
#define SB_LOAD_TILE(T) do { const int p0_ = 32 * (T); \
        if (SAMPLE) { const size_t ri0 = (T) < PAST / 32 ? (size_t)pt[p0_ >> 7] * PAGE + (p0_ & (PAGE - 1)) : 0; \
            _Pragma("unroll") for (int i = 0; i < 8; ++i) { const int id = lane + 64 * i, kk = id >> 4, cc = id & 15; \
                const float* kp = ((T) < PAST / 32 ? P.c_kvb + (ri0 + kk) * 1024 : newkvb + (kk < DECS ? kk : DECS - 1) * 1024) + h * 64 + 4 * cc; Kf[i] = *(const f32x4*)kp; Vf[i] = *(const f32x4*)(kp + 512); } } \
        else { _Pragma("unroll") for (int i = 0; i < 4; ++i) { const int id = lane + 64 * i, kk = id >> 3, cc = id & 7; const size_t ro = (size_t)(bs * SEQ + p0_ + kk) * 512 + h * 64 + 8 * cc; \
                Kh[i] = *(const half8*)(KB + ro); Vh[i] = *(const half8*)(VB + ro); } } } while (0)
    SB_LOAD_TILE(SAMPLE ? PAST / 32 : qt);
#pragma unroll 1
    for (int tile = SAMPLE ? PAST / 32 : qt; tile >= 0; --tile) {
        const int p0 = 32 * tile;
        if (SAMPLE) {
#pragma unroll
            for (int i = 0; i < 8; ++i) { const int id = lane + 64 * i, kk = id >> 4, cc = id & 15;
                *(LAS u32x2*)(kb + kk * VPITCH + cc * 8) = (u32x2){pkh(Kf[i][0], Kf[i][1]), pkh(Kf[i][2], Kf[i][3])};
                *(LAS u32x2*)(vbp + kk * VPITCH + cc * 8) = (u32x2){pkh(Vf[i][0], Vf[i][1]), pkh(Vf[i][2], Vf[i][3])}; }
        } else {
#pragma unroll
            for (int i = 0; i < 4; ++i) { const int id = lane + 64 * i, kk = id >> 3, cc = id & 7;
                *(LAS half8*)(kb + kk * VPITCH + cc * 16) = Kh[i]; *(LAS half8*)(vbp + kk * VPITCH + cc * 16) = Vh[i]; }
        }
        if (tile > 0) SB_LOAD_TILE(tile - 1);
        LDS_WAIT(); asm volatile("" ::: "memory");
        f32x16 s;
#pragma unroll
        for (int i = 0; i < 16; ++i) s[i] = 0.f;
#pragma unroll
        for (int ks = 0; ks < 4; ++ks) s = mfma32(*(LAS const half8*)(kb + r * VPITCH + (16 * ks + 8 * h2) * 2), Bq[ks], s);
        float sp[16], gs[4], pg[4];
#pragma unroll
        for (int i = 0; i < 16; ++i) { const float z = s[i] * 0.125f; const bool valid = p0 + crow(i, h2) < qpos;
            const float e = __builtin_amdgcn_exp2f(-fabsf(z) * LOG2E);
            const float v = fmaxf(z, 0.f) + __builtin_amdgcn_logf(1.0f + e) * LN2;
            sp[i] = valid ? v : 0.f; s[i] = valid ? z : -INFINITY; }
#pragma unroll
        for (int gi = 0; gi < 4; ++gi) { gs[gi] = (sp[4 * gi] + sp[4 * gi + 1]) + (sp[4 * gi + 2] + sp[4 * gi + 3]); pg[gi] = __shfl_xor(gs[gi], 32); }
        float base = carry;
        float a[16];
#pragma unroll
        for (int gi = 3; gi >= 0; --gi) { float c = base + (h2 == 0 ? pg[gi] : 0.f);
#pragma unroll
            for (int e = 3; e >= 0; --e) { c += sp[4 * gi + e]; a[4 * gi + e] = __builtin_amdgcn_exp2f((s[4 * gi + e] - c) * LOG2E); }
            base += gs[gi] + pg[gi]; }
        carry = base;
        half4 vt[8];
        tr_read8<0, 8 * VPITCH, 64, 8 * VPITCH + 64, 16 * VPITCH, 24 * VPITCH, 16 * VPITCH + 64, 24 * VPITCH + 64>(vb, vt);
#pragma unroll
        for (int s2 = 0; s2 < 2; ++s2) { half8 pf;
#pragma unroll
            for (int j = 0; j < 8; ++j) pf[j] = (f16)a[8 * s2 + j];
            O0 = mfma32(cat4(vt[4 * s2], vt[4 * s2 + 1]), pf, O0); O1 = mfma32(cat4(vt[4 * s2 + 2], vt[4 * s2 + 3]), pf, O1); }
        asm volatile("" ::: "memory");
        if (__all(carry >= 104.0f)) break;
    }
    if (!SAMPLE || r < 4) { f16* op = (f16*)(ws + WS_OAB) + (size_t)qrow * 1024 + 512 + h * 64 + 4 * h2;
#pragma unroll
        for (int gi = 0; gi < 4; ++gi) {
            *(u32x2*)(op + 8 * gi) = (u32x2){pkh(O0[4 * gi], O0[4 * gi + 1]), pkh(O0[4 * gi + 2], O0[4 * gi + 3])};
            *(u32x2*)(op + 32 + 8 * gi) = (u32x2){pkh(O1[4 * gi], O1[4 * gi + 1]), pkh(O1[4 * gi + 2], O1[4 * gi + 3])}; } }
}

#undef SB_LOAD_TILE
constexpr int NU_SIDX = DECB, NU_SSB = DECB, NU_PIDX = NB * (SEQ / 16), NU_PSB = NB * (SEQ / 32), NU_ALL = NU_SIDX + NU_SSB + NU_PIDX + NU_PSB;
__device__ __forceinline__ void p2_attention(const Frame& F, const Params& P, int qword = CW_QUEUE, int tmask = 127) {
    for (;;) {
        __syncthreads();
        if (F.tid == 0) F.MISC[16] = __hip_atomic_fetch_add(F.ctl + qword, 1u, RLX_AGENT);
        __syncthreads();
        int u = (int)F.MISC[16];
        if (u >= NU_ALL) break;
#ifndef NO_SIDX
        if (u < NU_SIDX) { if (tmask & 1) idx_unit<true>(F, P, u, 0, tmask >> 4); continue; }
#endif
        u -= NU_SIDX;
#ifndef NO_SSB
        if (u < NU_SSB) { if (tmask & 2) sb_item<true>(P, u, F.wave, 0, F.lds + F.wave * WBUF, F.lane); continue; }
#endif
        u -= NU_SSB;
#ifndef NO_PIDX
        if (u < NU_PIDX) { if (tmask & 4) idx_unit<false>(F, P, u & 3, SEQ / 16 - 1 - (u >> 2), tmask >> 4); continue; }
#endif
        u -= NU_PIDX;
#ifndef NO_PSB
        if (tmask & 8) sb_item<false>(P, u & 3, F.wave, SEQ / 32 - 1 - (u >> 2), F.lds + F.wave * WBUF, F.lane);
#endif
    }
}
__device__ __forceinline__ void p7_final(const Frame& F, const Params& P) {
    const float* SS = (const float*)(P.ws + WS_SS3);
    const int gw = F.bx * NWAVES + F.wave, NGW = F.G * NWAVES;
    for (int m = gw; m < MR; m += NGW) {
        const float rs = rstd_from_parts(SS, m);
        f32x4* yr = (f32x4*)(P.out + (m < MP ? O_Y_P + (size_t)m * DM : O_Y_S + (size_t)(m - MP) * DM)) + F.lane;
        const f32x4* gf = (const f32x4*)P.g_final + F.lane;
#pragma unroll
        for (int j = 0; j < 4; ++j) { const f32x4 v = yr[64 * j], g = gf[64 * j]; yr[64 * j] = (f32x4){v[0] * rs * g[0], v[1] * rs * g[1], v[2] * rs * g[2], v[3] * rs * g[3]}; }
    }
}

constexpr int N_PHASES = 8;
__global__ void __launch_bounds__(NWAVES * 64, 2) fwd(Params P) {
    extern __shared__ __attribute__((aligned(16))) unsigned char lds_raw[];
    Frame F;
    F.lds = (LAS unsigned char*)lds_raw;
    F.MISC = (volatile LAS unsigned*)(F.lds + MISC_OFF);
    F.tid = threadIdx.x; F.lane = F.tid & 63; F.wave = __builtin_amdgcn_readfirstlane(F.tid >> 6);
    F.G = gridDim.x; F.bx = blockIdx.x;
    F.ctl = (unsigned*)(P.ws + WS_CTL);
    if (F.tid < 64) F.MISC[F.tid] = 0u;
    __syncthreads();
    const bool multi = (P.ph_hi - P.ph_lo) > 1;
    XcdBarrier bar; bar.bar = F.ctl + CW_BAR; bar.x = 0; bar.st = nullptr;
    if (multi) bar = xcd_barrier_post(F.ctl + CW_BAR, F.MISC + 8);
    unsigned char* ws = P.ws;
    const int lo = P.ph_lo, hi = P.ph_hi;
#ifndef PHMASK
#define PHMASK 0xFF
#endif
#define IN(k) (((PHMASK >> (k)) & 1) && lo <= (k) && (k) < hi)
#define SEAM(k) do { if (IN(k) && IN((k) + 1)) xcd_barrier(bar); } while (0)

    if (IN(0)) { p0_prologue(F, P);
#ifdef PROBE_P0X2
        p0_prologue(F, P);
#endif
        SEAM(0); }
    if (IN(1)) {
        pg8::Gemm g{(const f16*)(ws + WS_XH), (const f16*)(ws + WS_WIN), DM, DM, DM}; pg8::StaticOrder S; S.init(MP, NIN, F.G, F.bx);
        EpiInProj E{(const float*)(ws + WS_RSTD1), (const f32x2*)(ws + WS_ROPE), P.out, ws};
        small_gemm_wg(F.lds, g, E, F.bx, F.G, (NIN / 256) * 32, 1, F.wave, F.lane);
        pg8::gemm_phase<EpiInProj, pg8::StaticOrder, true>(F.lds, g, S, E);
#if defined(PROBE_GX2) && ((PROBE_GX2 >> 1) & 1)
        __syncthreads(); pg8::gemm_phase<EpiInProj, pg8::StaticOrder, true>(F.lds, g, S, E);
#endif
        SEAM(1);
    }
    if (IN(2)) { p2_attention(F, P);
#ifdef PROBE_P2X2
        p2_attention(F, P, CW_QUEUE + 64, PROBE_P2X2);
#endif
        SEAM(2); }
    if (IN(3)) {
        pg8::Gemm g{(const f16*)(ws + WS_OAB), (const f16*)(ws + WS_WBR), DM, DM, 512}; pg8::PairOrder S; S.S.init(MP, DM, F.G, F.bx); S.K = 512;
        EpiBranch E{(const f16*)(ws + WS_G), (f16*)(ws + WS_MG)};
        small_gemm_wg(F.lds, g, E, F.bx, F.G, (DM / 256) * 32, 2, F.wave, F.lane);
        pg8::gemm_phase<EpiBranch, pg8::PairOrder, false>(F.lds, g, S, E);
#if defined(PROBE_GX2) && ((PROBE_GX2 >> 3) & 1)
        __syncthreads(); pg8::gemm_phase<EpiBranch, pg8::PairOrder, false>(F.lds, g, S, E);
#endif
        SEAM(3);
    }
    if (IN(4)) {
        pg8::Gemm g{(const f16*)(ws + WS_MG), (const f16*)(ws + WS_WO), DM, DM, DM}; pg8::StaticOrder S; S.init(MP, DM, F.G, F.bx);
        EpiWo E{P.x_p, P.x_s, (float*)(ws + WS_H), (f16*)(ws + WS_HH), (float*)(ws + WS_SS2)};
        small_gemm_wg(F.lds, g, E, F.bx, F.G, (DM / 256) * 32, 1, F.wave, F.lane);
        pg8::gemm_phase<EpiWo, pg8::StaticOrder, false>(F.lds, g, S, E);
#if defined(PROBE_GX2) && ((PROBE_GX2 >> 4) & 1)
        __syncthreads(); pg8::gemm_phase<EpiWo, pg8::StaticOrder, false>(F.lds, g, S, E);
#endif
        SEAM(4);
    }
    if (IN(5)) {
        pg8::Gemm g{(const f16*)(ws + WS_HH), (const f16*)(ws + WS_WGU), DM, DM, DM}; pg8::StaticOrder S; S.init(MP, NGU, F.G, F.bx);
        EpiGateUp E{(const float*)(ws + WS_SS2), (f16*)(ws + WS_ACT)};
        if (F.bx >= F.G / 2) small_gemm_wg(F.lds, g, E, F.bx - F.G / 2, F.G - F.G / 2, (NGU / 256) * 32, 1, F.wave, F.lane);
        pg8::gemm_phase<EpiGateUp, pg8::StaticOrder, true>(F.lds, g, S, E);
#if defined(PROBE_GX2) && ((PROBE_GX2 >> 5) & 1)
        __syncthreads(); pg8::gemm_phase<EpiGateUp, pg8::StaticOrder, true>(F.lds, g, S, E);
#endif
        SEAM(5);
    }
    if (IN(6)) {
        pg8::Gemm g{(const f16*)(ws + WS_ACT), (const f16*)(ws + WS_WDN), DFF, DFF, DFF}; pg8::StaticOrder S; S.init(MP, DM, F.G, F.bx);
        EpiDown E{(const float*)(ws + WS_H), P.out, (float*)(ws + WS_SS3)};
        small_gemm_wg(F.lds, g, E, F.bx, F.G, (DM / 256) * 32, 1, F.wave, F.lane);
        pg8::gemm_phase<EpiDown, pg8::StaticOrder, false>(F.lds, g, S, E);
#if defined(PROBE_GX2) && ((PROBE_GX2 >> 6) & 1)
        __syncthreads(); pg8::gemm_phase<EpiDown, pg8::StaticOrder, false>(F.lds, g, S, E);
#endif
        SEAM(6);
    }
    if (IN(7)) p7_final(F, P);
#undef IN
#undef SEAM
}

#ifndef MK_N_LAUNCHES
#define MK_N_LAUNCHES 1
#endif
extern "C" void kernel_launch(void* const* d_in, const int* in_sizes, int n_in, void* d_out, int out_size, void* d_ws, size_t ws_size, hipStream_t stream) {
    static int grid = 0;
    if (grid == 0) {
        if (n_in != 16 || out_size != (int)O_END || ws_size < WS_END) { fprintf(stderr, "kernel_launch: unexpected sizes (n_in %d, out %d, ws %zu, need %zu)\n", n_in, out_size, ws_size, (size_t)WS_END); grid = -1; return; }
        int dev = 0, cus = 0, per_cu = 0;
        if (hipGetDevice(&dev) != hipSuccess || hipDeviceGetAttribute(&cus, hipDeviceAttributeMultiprocessorCount, dev) != hipSuccess) { grid = -1; return; }
        if (hipFuncSetAttribute((const void*)fwd, hipFuncAttributeMaxDynamicSharedMemorySize, LDS_BYTES) != hipSuccess) { fprintf(stderr, "kernel_launch: hipFuncSetAttribute failed\n"); grid = -1; return; }
        if (hipOccupancyMaxActiveBlocksPerMultiprocessor(&per_cu, (const void*)fwd, NWAVES * 64, LDS_BYTES) != hipSuccess || per_cu < 1) { fprintf(stderr, "kernel_launch: occupancy query says %d\n", per_cu); }
        (void)hipGetLastError();
        grid = cus;
    }
    if (grid < 0) return;
    (void)hipMemsetAsync((char*)d_ws + WS_CTL, 0, CTL_ZERO_BYTES, stream);
    Params p{};
    p.x_p = (const float*)d_in[0]; p.x_s = (const float*)d_in[1]; p.c_kva = (const float*)d_in[2]; p.c_ki = (const float*)d_in[3]; p.c_kvb = (const float*)d_in[4]; p.pt = (const int*)d_in[5];
    p.w_in = (const float*)d_in[6]; p.w_bra = (const float*)d_in[7]; p.w_brb = (const float*)d_in[8]; p.w_o = (const float*)d_in[9]; p.g_attn = (const float*)d_in[10]; p.g_ffn = (const float*)d_in[11];
    p.w_gate = (const float*)d_in[12]; p.w_up = (const float*)d_in[13]; p.w_down = (const float*)d_in[14]; p.g_final = (const float*)d_in[15];
    p.out = (float*)d_out; p.ws = (unsigned char*)d_ws;
#if MK_N_LAUNCHES == 1
    p.ph_lo = 0; p.ph_hi = N_PHASES;
    hipLaunchKernelGGL(fwd, dim3(grid), dim3(NWAVES * 64), LDS_BYTES, stream, p);
#else
    for (int k = 0; k < N_PHASES; ++k) { p.ph_lo = k; p.ph_hi = k + 1; hipLaunchKernelGGL(fwd, dim3(grid), dim3(NWAVES * 64), LDS_BYTES, stream, p); }
#endif
}
```

```cpp
#include <hip/hip_runtime.h>
#include <cstdio>
#include <cstdint>

#define LAS __attribute__((address_space(3)))
#define GAS __attribute__((address_space(1)))
typedef _Float16 f16;
typedef _Float16 half8 __attribute__((ext_vector_type(8)));
typedef _Float16 half4 __attribute__((ext_vector_type(4)));
typedef _Float16 half2v __attribute__((ext_vector_type(2)));
typedef float f32x2 __attribute__((ext_vector_type(2)));
typedef float f32x4 __attribute__((ext_vector_type(4)));
typedef float f32x16 __attribute__((ext_vector_type(16)));
typedef unsigned u32x4 __attribute__((ext_vector_type(4)));
typedef unsigned u32x2 __attribute__((ext_vector_type(2)));
typedef short s16x4 __attribute__((ext_vector_type(4)));

namespace pg8 {
constexpr int BM = 256, BK = 64, HALF = 128, HTB = HALF * BK * 2  , STAGE_BYTES = 8 * HTB, NXCD = 8, WGM = 8;

__host__ __device__ __forceinline__ int lds_byte(int r, int c) { const int st = (r >> 4) * 2 + (c >> 5), rr = r & 15, cc = c & 31, ob = rr * 64 + cc * 2; return st * 1024 + (ob ^ (((ob >> 9) & 1) << 5)); }
__host__ __device__ __forceinline__ void stage_rc(int b, int& R, int& C) { const int st = b / 1024, sb = b % 1024, swz = sb ^ (((sb >> 9) & 1) << 5); R = (st >> 1) * 16 + swz / 64; C = (st & 1) * 32 + (swz % 64) / 2; }
__host__ __device__ __forceinline__ int perm32(int rho) { const int n = rho >> 4, i = rho & 15; return 8 * (i >> 2) + 4 * n + (i & 3); }

struct Unit { int pm, pn, ka, kb, sub; };
struct Gemm { const f16* A; const f16* Bt; int lda, ldb, K; };

struct StaticOrder {
    int nM, nN, nwg, G, c;
    __host__ __device__ void init(int M, int N, int G_, int c_) { nM = M / BM; nN = N / BM; nwg = nM * nN; G = G_; c = c_; }
    __host__ __device__ bool next(int i, Unit& u) const {
        const long L = (long)i * G + c; if (L >= nwg) return false;
        int wgid = (int)L; { const int q = nwg / NXCD, r = nwg % NXCD, xcd = wgid % NXCD, off = wgid / NXCD; wgid = (xcd < r ? xcd * (q + 1) : r * (q + 1) + (xcd - r) * q) + off; }
        const int nig = WGM * nN, gid = wgid / nig, fm = gid * WGM, gsz = (nM - fm) < WGM ? (nM - fm) : WGM;
        u.pm = fm + ((wgid % nig) % gsz); u.pn = (wgid % nig) / gsz; u.ka = 0; u.kb = 0; u.sub = 1; return true;
    }
};
struct PairOrder {
    StaticOrder S; int K;
    __host__ __device__ bool next(int i, Unit& u) const { if (!S.next(i >> 1, u)) return false; u.sub = i & 1; u.ka = u.kb = (i & 1) * K; return true; }
};

template <class Epi, class Sched, bool ALIGN_EPI = false>
__device__ __forceinline__ void gemm_phase(LAS unsigned char* lds, const Gemm g, const Sched& S, const Epi& E) {
    const int tid = threadIdx.x, wid = __builtin_amdgcn_readfirstlane(tid >> 6), lane = tid & 63, wr = wid >> 2, wc = wid & 3, fr = lane & 15, fq = lane >> 4;
    const int nt = g.K / BK;
    unsigned voffA[2], voffB[2];
#pragma unroll
    for (int i = 0; i < 2; ++i) { int R, C; stage_rc(tid * 16 + i * 8192, R, C); const int Rb = (R & ~31) + perm32(R & 31);
        voffA[i] = (unsigned)(R * g.lda + C) * 2u; voffB[i] = (unsigned)(Rb * g.ldb + C) * 2u; }
    const size_t kstep = (size_t)(BK * 2);
    const size_t hstepA = (size_t)HALF * g.lda * 2, hstepB = (size_t)HALF * g.ldb * 2;
    const size_t tstepA = 2 * hstepA, tstepB = 2 * hstepB;
    const unsigned ldsw = (unsigned)wid * 1024u;
    const int aoff = lds_byte(wr * 64 + fr, fq * 8), boff = lds_byte(wc * 32 + fr, fq * 8);
#define PG8_SA(b, h) (((b) * 2 + (h)) * HTB)
#define PG8_SB(b, h) ((4 + (b) * 2 + (h)) * HTB)
#define PG8_STAGE(bufoff, gbase, voff) do { _Pragma("unroll") for (int _i = 0; _i < 2; ++_i) \
        __builtin_amdgcn_global_load_lds((const unsigned*)((const char*)(gbase) + (voff)[_i]), (LAS unsigned*)(lds + (bufoff) + ldsw + _i * 8192), 16, 0, 0); } while (0)
#define PG8_LDA(dst, b, h) do { _Pragma("unroll") for (int m = 0; m < 4; ++m) _Pragma("unroll") for (int k = 0; k < 2; ++k) dst[m][k] = *(const LAS half8*)(lds + PG8_SA(b, h) + aoff + m * 2048 + k * 1024); } while (0)
#define PG8_LDB(dst, b, h) do { _Pragma("unroll") for (int n = 0; n < 2; ++n) _Pragma("unroll") for (int k = 0; k < 2; ++k) dst[n][k] = *(const LAS half8*)(lds + PG8_SB(b, h) + boff + n * 2048 + k * 1024); } while (0)
#define PG8_MMA(ai, bj, At, Bt) do { __builtin_amdgcn_s_setprio(1); _Pragma("unroll") for (int m = 0; m < 4; ++m) _Pragma("unroll") for (int n = 0; n < 2; ++n) _Pragma("unroll") for (int k = 0; k < 2; ++k) \
        acc[ai][bj][m][n] = __builtin_amdgcn_mfma_f32_16x16x32_f16(Bt[n][k], At[m][k], acc[ai][bj][m][n], 0, 0, 0); __builtin_amdgcn_s_setprio(0); } while (0)
#define PG8_WAIT_V(n) asm volatile("s_waitcnt vmcnt(" #n ")" ::: "memory")
#define PG8_WAIT_L(n) asm volatile("s_waitcnt lgkmcnt(" #n ")" ::: "memory")
#define PG8_BAR __builtin_amdgcn_s_barrier()
#define PG8_SCHED __builtin_amdgcn_sched_barrier(0)
#define PG8_ZERO() do { _Pragma("unroll") for (int a = 0; a < 2; ++a) _Pragma("unroll") for (int b = 0; b < 2; ++b) _Pragma("unroll") for (int m = 0; m < 4; ++m) _Pragma("unroll") for (int n = 0; n < 2; ++n) acc[a][b][m][n] = (f32x4){0.f, 0.f, 0.f, 0.f}; } while (0)
    Unit cur, nxt; int ui = 0;
    if (!S.next(0, cur)) return;
    f32x4 acc[2][2][4][2];
    PG8_ZERO();
    half8 At[4][2], B0[2][2], B1[2][2];
    const char* cA = (const char*)g.A + (size_t)cur.pm * tstepA + (size_t)cur.ka * 2; const char* cB = (const char*)g.Bt + (size_t)cur.pn * tstepB + (size_t)cur.kb * 2;
    PG8_STAGE(PG8_SB(0, 0), cB, voffB); PG8_STAGE(PG8_SB(0, 1), cB + hstepB, voffB); PG8_STAGE(PG8_SA(0, 0), cA, voffA); PG8_STAGE(PG8_SA(0, 1), cA + hstepA, voffA);
    if (wr == 1) PG8_BAR;
    PG8_WAIT_V(2); PG8_BAR;
    PG8_STAGE(PG8_SB(1, 0), cB + kstep, voffB); PG8_STAGE(PG8_SA(1, 0), cA + kstep, voffA); PG8_STAGE(PG8_SB(1, 1), cB + hstepB + kstep, voffB);
    PG8_WAIT_V(6); PG8_BAR;
    for (;;) {
        const bool has_next = S.next(ui + 1, nxt);
        const char* nA = has_next ? (const char*)g.A + (size_t)nxt.pm * tstepA + (size_t)nxt.ka * 2 : cA; const char* nB = has_next ? (const char*)g.Bt + (size_t)nxt.pn * tstepB + (size_t)nxt.kb * 2 : cB;
        for (int t = 0; t < nt; t += 2) {
            const bool last = (t == nt - 2);
            const char* a1 = cA + (size_t)(t + 1) * kstep;
            const char* a2 = last ? nA : cA + (size_t)(t + 2) * kstep; const char* b2 = last ? nB : cB + (size_t)(t + 2) * kstep;
            const char* a3 = a2 + kstep; const char* b3 = b2 + kstep;
            PG8_LDB(B0, 0, 0); PG8_LDB(B1, 0, 1); PG8_SCHED; PG8_LDA(At, 0, 0); PG8_STAGE(PG8_SA(1, 1), a1 + hstepA, voffA);
            PG8_WAIT_V(8); PG8_WAIT_L(0); PG8_BAR; PG8_MMA(0, 0, At, B0); PG8_MMA(0, 1, At, B1); PG8_BAR; PG8_SCHED;
            PG8_LDA(At, 0, 1); PG8_STAGE(PG8_SB(0, 0), b2, voffB); PG8_STAGE(PG8_SB(0, 1), b2 + hstepB, voffB); PG8_STAGE(PG8_SA(0, 0), a2, voffA);
            PG8_WAIT_V(8); PG8_WAIT_L(0); PG8_BAR; PG8_MMA(1, 0, At, B0); PG8_MMA(1, 1, At, B1); PG8_BAR; PG8_SCHED;
            PG8_LDB(B0, 1, 0); PG8_LDB(B1, 1, 1); PG8_SCHED; PG8_LDA(At, 1, 0); PG8_STAGE(PG8_SA(0, 1), a2 + hstepA, voffA);
            PG8_WAIT_V(8); PG8_WAIT_L(0); PG8_BAR; PG8_MMA(0, 0, At, B0); PG8_MMA(0, 1, At, B1); PG8_BAR; PG8_SCHED;
            PG8_LDA(At, 1, 1); PG8_STAGE(PG8_SB(1, 0), b3, voffB); PG8_STAGE(PG8_SB(1, 1), b3 + hstepB, voffB); PG8_STAGE(PG8_SA(1, 0), a3, voffA);
            PG8_WAIT_V(8); PG8_WAIT_L(0); PG8_BAR; PG8_MMA(1, 0, At, B0); PG8_MMA(1, 1, At, B1); PG8_BAR; PG8_SCHED;
        }
        if constexpr (ALIGN_EPI) { if (wr == 0) PG8_BAR; }
        E(acc, cur, wr, wc, fr, fq);
        if (!has_next) break;
        if (E.zero_after(cur)) PG8_ZERO();
        cur = nxt; cA = nA; cB = nB; ++ui;
        if constexpr (ALIGN_EPI) { if (wr == 1) PG8_BAR; }
    }
    PG8_WAIT_V(0);
    if constexpr (!ALIGN_EPI) { if (wr == 0) PG8_BAR; }
    PG8_BAR;
#undef PG8_SA
#undef PG8_SB
#undef PG8_STAGE
#undef PG8_LDA
#undef PG8_LDB
#undef PG8_MMA
#undef PG8_WAIT_V
#undef PG8_WAIT_L
#undef PG8_BAR
#undef PG8_SCHED
#undef PG8_ZERO
}
}
#define MK_N_LAUNCHES 1

constexpr int DM = 1024, NB = 4, SEQ = 4096, DECB = 32, DECS = 4, PAST = 8192, PAGE = 128, NPAGES = PAST / PAGE;
constexpr int MP = NB * SEQ, MS = DECB * DECS, MR = MP + MS, MT = 16640;
constexpr int HD = 64, IN_W = 4936, NIN = 5120, DFF = 2816, NGU = 2 * DFF, TOPK = 256;
constexpr int NKS = PAST + DECS;
constexpr float RMS_EPS = 1e-6f;
constexpr int NROPE = SEQ + DECS;
constexpr size_t O_Y_P = 0, O_Y_S = O_Y_P + (size_t)MP * DM, O_KVA_P = O_Y_S + (size_t)MS * DM, O_KI_P = O_KVA_P + (size_t)MP * 256, O_KVB_P = O_KI_P + (size_t)MP * 64,
                 O_KVA_S = O_KVB_P + (size_t)MP * 1024, O_KI_S = O_KVA_S + (size_t)MS * 256, O_KVB_S = O_KI_S + (size_t)MS * 64, O_END = O_KVB_S + (size_t)MS * 1024;
static_assert(O_END == 39100416, "d_out size");

constexpr size_t MiB = 1u << 20;
constexpr size_t al(size_t x) { return (x + MiB - 1) / MiB * MiB; }
constexpr size_t WS_CTL = 0, CTL_ZERO_BYTES = 1 * MiB;
constexpr size_t WS_WIN = 2 * MiB;
constexpr size_t WS_WBR = WS_WIN + al((size_t)NIN * DM * 2);
constexpr size_t WS_WO = WS_WBR + al((size_t)DM * DM * 2);
constexpr size_t WS_WGU = WS_WO + al((size_t)DM * DM * 2);
constexpr size_t WS_WDN = WS_WGU + al((size_t)NGU * DM * 2);
constexpr size_t WS_ROPE = WS_WDN + al((size_t)DM * DFF * 2);
constexpr size_t WS_RSTD1 = WS_ROPE + al((size_t)NROPE * 32 * 8);
constexpr size_t WS_SS2 = WS_RSTD1 + al((size_t)MT * 4);
constexpr size_t WS_SS3 = WS_SS2 + al((size_t)MT * 16 * 4);
constexpr size_t WS_XH = WS_SS3 + al((size_t)MT * 16 * 4);
constexpr size_t WS_QA = WS_XH + al((size_t)MT * DM * 2);
constexpr size_t WS_KA = WS_QA + al((size_t)MT * 512 * 2);
constexpr size_t WS_VA = WS_KA + al((size_t)MT * 128 * 2);
constexpr size_t WS_QI = WS_VA + al((size_t)MT * 128 * 2);
constexpr size_t WS_KI = WS_QI + al((size_t)MT * 512 * 2);
constexpr size_t WS_WI = WS_KI + al((size_t)MT * 64 * 2);
constexpr size_t WS_QB = WS_WI + al((size_t)MT * 8 * 4);
constexpr size_t WS_KB = WS_QB + al((size_t)MT * 512 * 2);
constexpr size_t WS_VB = WS_KB + al((size_t)MT * 512 * 2);
constexpr size_t WS_G = WS_VB + al((size_t)MT * 512 * 2);
constexpr size_t WS_OAB = WS_G + al((size_t)MT * 2048 * 2);
constexpr size_t WS_MG = WS_XH;
constexpr size_t WS_H = WS_G;
constexpr size_t WS_HH = WS_OAB;
constexpr size_t WS_ACT = WS_QA;
static_assert(WS_ACT + (size_t)MT * DFF * 2 <= WS_G && (size_t)MT * DM * 4 <= (size_t)MT * 2048 * 2, "overlays fit");
constexpr size_t WS_MASK = WS_OAB + al((size_t)MT * DM * 2);
constexpr size_t WS_END = WS_MASK + al((size_t)MP * 512);
constexpr int CW_QUEUE = 64;
constexpr int CW_BAR = 4096;

constexpr int RING_BYTES = 131072;
constexpr int LDS_BYTES = 163840;
constexpr int MISC_OFF = LDS_BYTES - 256;
constexpr int NWAVES = 8;

#define RLX_AGENT __ATOMIC_RELAXED, __HIP_MEMORY_SCOPE_AGENT
#define LDS_WAIT() asm volatile("s_waitcnt lgkmcnt(0)" ::: "memory")
#define VM_WAIT() asm volatile("s_waitcnt vmcnt(0)" ::: "memory")

#define XB_TMO      128
#define XB_XCNT(j)  (256  + 64 * (j))
#define XB_XSUB(j)  (1280 + 64 * (j))
#define XB_XGEN(j)  (2304 + 64 * (j))
#define XB_TOP      3328
#define XB_TOPGEN   3392
#define XCD_BAR_WORDS 3456
#define XB_SPIN_CAP (1u << 18)

__device__ __forceinline__ unsigned xb_ld(unsigned* p)              { return __hip_atomic_load(p, __ATOMIC_RELAXED, __HIP_MEMORY_SCOPE_AGENT); }
__device__ __forceinline__ unsigned xb_add(unsigned* p, unsigned v) { return __hip_atomic_fetch_add(p, v, __ATOMIC_RELAXED, __HIP_MEMORY_SCOPE_AGENT); }
__device__ __forceinline__ unsigned xb_xcc_id() { return (unsigned)__builtin_amdgcn_s_getreg((3 << 11) | 20) & 0xFu; }
#define XB_SPIN(cond, bar) do { unsigned _sp = 0; while (cond) { __builtin_amdgcn_s_sleep(1); \
    if ((++_sp & 255u) == 0u) { if (xb_ld(&(bar)[XB_TMO])) break; if (_sp > XB_SPIN_CAP) { atomicAdd(&(bar)[XB_TMO], 1u); break; } } } } while (0)

struct XcdBarrier { unsigned* bar; unsigned x; volatile LAS unsigned* st; };

__device__ __forceinline__ XcdBarrier xcd_barrier_post(unsigned* bar, volatile LAS unsigned* st) {
    XcdBarrier b; b.bar = bar; b.x = xb_xcc_id(); b.st = st;
    if (threadIdx.x == 0) (void)xb_add(&bar[XB_XCNT(b.x)], 1u);
    return b;
}
__device__ __forceinline__ void xcd_barrier_complete(unsigned* bar, unsigned x, unsigned& nloc, unsigned& nx) {
    const unsigned G = gridDim.x * gridDim.y * gridDim.z;
    unsigned sum, cnt, mine, sp = 0u;
    for (;;) {
        sum = 0u; cnt = 0u; mine = 0u;
#pragma unroll
        for (unsigned j = 0; j < 16; ++j) { const unsigned c = xb_ld(&bar[XB_XCNT(j)]); sum += c; cnt += (c > 0u) ? 1u : 0u; mine = (j == x) ? c : mine; }
        if (sum == G) break;
        __builtin_amdgcn_s_sleep(1);
        if ((++sp & 255u) == 0u) { if (xb_ld(&bar[XB_TMO])) break; if (sp > XB_SPIN_CAP) { atomicAdd(&bar[XB_TMO], 1u); break; } }
    }
    nloc = mine > 0u ? mine : 1u; nx = cnt > 0u ? cnt : 1u;
}
__device__ __forceinline__ void xcd_barrier(const XcdBarrier& b) {
    asm volatile("s_waitcnt vmcnt(0)" ::: "memory");
    __syncthreads();
    if (threadIdx.x == 0) {
        unsigned* bar = b.bar;
        __builtin_amdgcn_s_waitcnt(0);
        unsigned nloc = b.st[0], nx = b.st[1];
        if (nloc == 0u) { xcd_barrier_complete(bar, b.x, nloc, nx); b.st[0] = nloc; b.st[1] = nx; }
        const unsigned old = xb_add(&bar[XB_XSUB(b.x)], 1u);
        const unsigned gen = old / nloc;
        if (old + 1u == (gen + 1u) * nloc) {
            __builtin_amdgcn_fence(__ATOMIC_RELEASE, "agent");
            asm volatile("s_waitcnt vmcnt(0)" ::: "memory");
            const unsigned og = xb_add(&bar[XB_TOP], 1u);
            const unsigned tg = og / nx;
            if (og + 1u == (tg + 1u) * nx) xb_add(&bar[XB_TOPGEN], 1u);
            else XB_SPIN(xb_ld(&bar[XB_TOPGEN]) == tg, bar);
            __builtin_amdgcn_fence(__ATOMIC_ACQUIRE, "agent");
            xb_add(&bar[XB_XGEN(b.x)], 1u);
            asm volatile("s_waitcnt vmcnt(0)" ::: "memory");
        } else {
            XB_SPIN(xb_ld(&bar[XB_XGEN(b.x)]) == gen, bar);
            __builtin_amdgcn_fence(__ATOMIC_ACQUIRE, "agent");
            asm volatile("s_waitcnt vmcnt(0)" ::: "memory");
        }
    }
    __syncthreads();
}

struct Params {
    const float *x_p, *x_s, *c_kva, *c_ki, *c_kvb; const int* pt;
    const float *w_in, *w_bra, *w_brb, *w_o, *g_attn, *g_ffn, *w_gate, *w_up, *w_down, *g_final;
    float* out; unsigned char* ws;
    int ph_lo, ph_hi;
};
struct Frame {
    LAS unsigned char* lds; volatile LAS unsigned* MISC; unsigned* ctl;
    int tid, lane, wave, G, bx;
};
__device__ __forceinline__ float wave_sum(float v) {
#pragma unroll
    for (int o = 1; o < 64; o <<= 1) v += __shfl_xor(v, o);
    return v;
}
__device__ __forceinline__ unsigned pkh(float lo, float hi) { half2v h = {(f16)lo, (f16)hi}; return __builtin_bit_cast(unsigned, h); }
__device__ __forceinline__ u32x4 pk8(const float* v) { u32x4 w; w.x = pkh(v[0], v[1]); w.y = pkh(v[2], v[3]); w.z = pkh(v[4], v[5]); w.w = pkh(v[6], v[7]); return w; }
__host__ __device__ __forceinline__ int in_col(int hs, int d) { return hs < 21 ? hs * 64 + d : (hs == 21 ? 1344 + d : 1352 + (hs - 22) * 64 + d); }

__device__ __forceinline__ void tr_item(const float* __restrict__ W, int ldw, int k0, int L0, int nvalid, const float* __restrict__ scale, f16* dst, int lddst, LAS float* scr, int lane) {
#pragma unroll 8
    for (int i = 0; i < 32; ++i) { const int kk = 2 * i + (lane >> 5), c = lane & 31; float v = 0.f;
        if (c < nvalid) { v = W[(size_t)(k0 + kk) * ldw + L0 + c]; if (scale) v *= scale[k0 + kk]; }
        scr[kk * 33 + c] = v; }
    LDS_WAIT(); asm volatile("" ::: "memory");
    const int c8 = lane & 7;
#pragma unroll
    for (int j = 0; j < 4; ++j) { const int n = (lane >> 3) + 8 * j; const LAS float* s = scr + (8 * c8) * 33 + n;
        u32x4 o; o.x = pkh(s[0 * 33], s[1 * 33]); o.y = pkh(s[2 * 33], s[3 * 33]); o.z = pkh(s[4 * 33], s[5 * 33]); o.w = pkh(s[6 * 33], s[7 * 33]);
        *(u32x4*)(dst + (size_t)n * lddst + 8 * c8) = o; }
    LDS_WAIT(); asm volatile("" ::: "memory");
}

__device__ __forceinline__ void p0_prologue(const Frame& F, const Params& P) {
    unsigned char* ws = P.ws;
    LAS float* scr = (LAS float*)(F.lds + F.wave * 16384);
    const int gw = F.bx * NWAVES + F.wave, NGW = F.G * NWAVES;
    constexpr int I_IN = 16 * (NIN / 32), I_BR = 8 * 32, I_O = 16 * 32, I_GU = 16 * (NGU / 32), I_DN = (DFF / 64) * 32;
    constexpr int NITEMS = I_IN + 2 * I_BR + I_O + I_GU + I_DN;
    for (int it = gw; it < NITEMS; it += NGW) {
        int r = it;
        if (r < I_IN) { const int nb = r % (NIN / 32), kb = r / (NIN / 32), n0 = 32 * nb, pn = n0 >> 8, bj = (n0 >> 7) & 1, wc = (n0 >> 5) & 3, hs = 4 * pn + wc;
            const int nvalid = hs == 21 ? (bj == 0 ? 8 : 0) : (hs < 78 ? 32 : 0);
            tr_item(P.w_in, IN_W, 64 * kb, in_col(hs < 78 ? hs : 0, 32 * bj), nvalid, P.g_attn, (f16*)(ws + WS_WIN) + (size_t)n0 * DM + 64 * kb, DM, scr, F.lane); continue; }
        r -= I_IN;
        if (r < I_BR) { const int nb = r % 32, kb = r / 32; tr_item(P.w_bra, DM, 64 * kb, 32 * nb, 32, nullptr, (f16*)(ws + WS_WBR) + (size_t)(32 * nb) * DM + 64 * kb, DM, scr, F.lane); continue; }
        r -= I_BR;
        if (r < I_BR) { const int nb = r % 32, kb = r / 32; tr_item(P.w_brb, DM, 64 * kb, 32 * nb, 32, nullptr, (f16*)(ws + WS_WBR) + (size_t)(32 * nb) * DM + 512 + 64 * kb, DM, scr, F.lane); continue; }
        r -= I_BR;
        if (r < I_O) { const int nb = r % 32, kb = r / 32; tr_item(P.w_o, DM, 64 * kb, 32 * nb, 32, nullptr, (f16*)(ws + WS_WO) + (size_t)(32 * nb) * DM + 64 * kb, DM, scr, F.lane); continue; }
        r -= I_O;
        if (r < I_GU) { const int nb = r % (NGU / 32), kb = r / (NGU / 32), n0 = 32 * nb, pn = n0 >> 8, bj = (n0 >> 7) & 1, j0 = n0 & 127;
            tr_item(bj ? P.w_up : P.w_gate, DFF, 64 * kb, 128 * pn + j0, 32, P.g_ffn, (f16*)(ws + WS_WGU) + (size_t)n0 * DM + 64 * kb, DM, scr, F.lane); continue; }
        r -= I_GU;
        { const int nb = r % 32, kb = r / 32; tr_item(P.w_down, DM, 64 * kb, 32 * nb, 32, nullptr, (f16*)(ws + WS_WDN) + (size_t)(32 * nb) * DFF + 64 * kb, DFF, scr, F.lane); }
    }
    float* rstd1 = (float*)(ws + WS_RSTD1);
    for (int m = gw; m < MT; m += NGW) {
        u32x2* o8 = (u32x2*)((f16*)(ws + WS_XH) + (size_t)m * DM) + F.lane;
        if (m < MR) {
            const float* xrow = m < MP ? P.x_p + (size_t)m * DM : P.x_s + (size_t)(m - MP) * DM;
            const f32x4* xr = (const f32x4*)xrow + F.lane;
            f32x4 v[4]; float s = 0.f;
#pragma unroll
            for (int j = 0; j < 4; ++j) { v[j] = xr[64 * j]; s += (v[j].x * v[j].x + v[j].y * v[j].y) + (v[j].z * v[j].z + v[j].w * v[j].w); }
            s = wave_sum(s);
            if (F.lane == 0) rstd1[m] = 1.0f / sqrtf(s * (1.0f / DM) + RMS_EPS);
#pragma unroll
            for (int j = 0; j < 4; ++j) o8[64 * j] = (u32x2){pkh(v[j].x, v[j].y), pkh(v[j].z, v[j].w)};
        } else {
            if (F.lane == 0) rstd1[m] = 0.f;
#pragma unroll
            for (int j = 0; j < 4; ++j) o8[64 * j] = (u32x2){0u, 0u};
        }
    }
    f32x2* rope = (f32x2*)(ws + WS_ROPE);
    for (int e = F.bx * (NWAVES * 64) + F.tid; e < NROPE * 32; e += F.G * NWAVES * 64) {
        const int p = e >> 5, i = e & 31, pos = p < SEQ ? p : PAST + (p - SEQ);
        const float inv = (float)exp2(-(double)i * (13.287712379549449 / 32.0));
        const float ang = (float)pos * inv;
        const double a = (double)ang, n = rint(a * 0.15915494309189535);
        double r = fma(-n, 6.283185307179586, a); r = fma(-n, 2.4492935982947064e-16, r);
        rope[e] = (f32x2){cosf((float)r), sinf((float)r)};
    }
}
__device__ __forceinline__ void ld8(const f32x4 (&a)[2], float* v) { v[0] = a[0][0]; v[1] = a[0][1]; v[2] = a[0][2]; v[3] = a[0][3]; v[4] = a[1][0]; v[5] = a[1][1]; v[6] = a[1][2]; v[7] = a[1][3]; }
__device__ __forceinline__ void st8f(float* p, const float* v) { *(f32x4*)p = (f32x4){v[0], v[1], v[2], v[3]}; *(f32x4*)(p + 4) = (f32x4){v[4], v[5], v[6], v[7]}; }
__device__ __forceinline__ void st8h(f16* p, const float* v) { *(u32x4*)p = pk8(v); }
__device__ __forceinline__ void ld8h(const f16* p, float* v) { const half8 h = *(const half8*)p;
#pragma unroll
    for (int i = 0; i < 8; ++i) v[i] = (float)h[i]; }
#define EPI_CALL_ROWS() _Pragma("unroll") for (int ai = 0; ai < 2; ++ai) _Pragma("unroll") for (int m = 0; m < 4; ++m) row_op(acc[ai][0][m], acc[ai][1][m], u.pm * 256 + ai * 128 + wr * 64 + m * 16 + fr, u, wc, fq)

struct EpiInProj {
    const float* rstd; const f32x2* rope; float* out; unsigned char* ws;
    __device__ __forceinline__ bool zero_after(const pg8::Unit&) const { return true; }
    __device__ __forceinline__ void row_op(f32x4 (&a0)[2], f32x4 (&a1)[2], int row, const pg8::Unit& u, int wc, int fq) const {
        const int hs = 4 * u.pn + wc, d0 = 8 * fq;
        if (hs >= 78 || row >= MR) return;
        bool do_rope = false; int func = 0  ;
        size_t o32p = 0, o32s = 0; int p32 = 0; bool has32 = false;
        f16* o16 = nullptr; int p16 = 0;
        if (hs < 8)        { do_rope = true; o16 = (f16*)(ws + WS_QA) + hs * 64; p16 = 512; }
        else if (hs < 10)  { do_rope = true; o16 = (f16*)(ws + WS_KA) + (hs - 8) * 64; p16 = 128; has32 = true; o32p = O_KVA_P + (hs - 8) * 64; o32s = O_KVA_S + (hs - 8) * 64; p32 = 256; }
        else if (hs < 12)  { o16 = (f16*)(ws + WS_VA) + (hs - 10) * 64; p16 = 128; has32 = true; o32p = O_KVA_P + 128 + (hs - 10) * 64; o32s = O_KVA_S + 128 + (hs - 10) * 64; p32 = 256; }
        else if (hs < 20)  { do_rope = true; o16 = (f16*)(ws + WS_QI) + (hs - 12) * 64; p16 = 512; }
        else if (hs == 20) { do_rope = true; o16 = (f16*)(ws + WS_KI); p16 = 64; has32 = true; o32p = O_KI_P; o32s = O_KI_S; p32 = 64; }
        else if (hs == 21) { func = 2; }
        else if (hs < 30)  { o16 = (f16*)(ws + WS_QB) + (hs - 22) * 64; p16 = 512; }
        else if (hs < 38)  { o16 = (f16*)(ws + WS_KB) + (hs - 30) * 64; p16 = 512; has32 = true; o32p = O_KVB_P + (hs - 30) * 64; o32s = O_KVB_S + (hs - 30) * 64; p32 = 1024; }
        else if (hs < 46)  { o16 = (f16*)(ws + WS_VB) + (hs - 38) * 64; p16 = 512; has32 = true; o32p = O_KVB_P + 512 + (hs - 38) * 64; o32s = O_KVB_S + 512 + (hs - 38) * 64; p32 = 1024; }
        else               { func = 1; o16 = (f16*)(ws + WS_G) + (hs - 46) * 64; p16 = 2048; }
        const float rs = rstd[row];
        float v1[8], v2[8]; ld8(a0, v1); ld8(a1, v2);
#pragma unroll
        for (int i = 0; i < 8; ++i) { v1[i] *= rs; v2[i] *= rs; }
        if (func == 2) { if (fq == 0) { float* w = (float*)(ws + WS_WI) + (size_t)row * 8;
#pragma unroll
            for (int i = 0; i < 8; ++i) v1[i] *= 0.35355339059327373f; st8f(w, v1); } return; }
        if (do_rope) {
            const int pidx = row < MP ? (row & (SEQ - 1)) : SEQ + ((row - MP) & (DECS - 1));
            const f32x4* rp = (const f32x4*)(rope + (size_t)pidx * 32 + d0);
#pragma unroll
            for (int j = 0; j < 4; ++j) { const f32x4 cs = rp[j];
                const float x0 = v1[2 * j], y0 = v2[2 * j], x1 = v1[2 * j + 1], y1 = v2[2 * j + 1];
                v1[2 * j] = x0 * cs[0] - y0 * cs[1]; v2[2 * j] = y0 * cs[0] + x0 * cs[1];
                v1[2 * j + 1] = x1 * cs[2] - y1 * cs[3]; v2[2 * j + 1] = y1 * cs[2] + x1 * cs[3]; }
        }
        if (func == 1) {
#pragma unroll
            for (int i = 0; i < 8; ++i) { v1[i] = fmaxf(1.0f / (1.0f + __expf(-v1[i])), 6.0e-8f); v2[i] = fmaxf(1.0f / (1.0f + __expf(-v2[i])), 6.0e-8f); }
        }
        if (has32) { float* o = out + (row < MP ? o32p + (size_t)row * p32 : o32s + (size_t)(row - MP) * p32) + d0; st8f(o, v1); st8f(o + 32, v2); }
        f16* oh = o16 + (size_t)row * p16 + d0; st8h(oh, v1); st8h(oh + 32, v2);
    }
    __device__ __forceinline__ void operator()(f32x4 (&acc)[2][2][4][2], const pg8::Unit& u, int wr, int wc, int fr, int fq) const { EPI_CALL_ROWS(); }
};

struct EpiBranch {
    const f16* G; f16* MG;
    __device__ __forceinline__ bool zero_after(const pg8::Unit& u) const { return u.sub != 0; }
    __device__ __forceinline__ void row_op(f32x4 (&a0)[2], f32x4 (&a1)[2], int row, const pg8::Unit& u, int wc, int fq) const {
        if (row >= MR) return;
#pragma unroll
        for (int bj = 0; bj < 2; ++bj) { const int col = u.pn * 256 + bj * 128 + wc * 32 + 8 * fq; f32x4 (&a)[2] = bj ? a1 : a0;
            float g1[8]; ld8h(G + (size_t)row * 2048 + 1024 + col, g1);
            if (u.sub == 0) { float g0[8]; ld8h(G + (size_t)row * 2048 + col, g0);
#pragma unroll
                for (int i = 0; i < 8; ++i) a[i >> 2][i & 3] *= g0[i] / g1[i];
            } else { float v[8]; ld8(a, v);
#pragma unroll
                for (int i = 0; i < 8; ++i) v[i] *= g1[i];
                st8h(MG + (size_t)row * DM + col, v); }
        }
    }
    __device__ __forceinline__ void operator()(f32x4 (&acc)[2][2][4][2], const pg8::Unit& u, int wr, int wc, int fr, int fq) const { EPI_CALL_ROWS(); }
};

struct EpiWo {
    const float *x_p, *x_s; float* H; f16* HH; float* SS;
    __device__ __forceinline__ bool zero_after(const pg8::Unit&) const { return true; }
    __device__ __forceinline__ void row_op(f32x4 (&a0)[2], f32x4 (&a1)[2], int row, const pg8::Unit& u, int wc, int fq) const {
        float ss = 0.f;
        if (row < MR) { const float* xr = row < MP ? x_p + (size_t)row * DM : x_s + (size_t)(row - MP) * DM;
#pragma unroll
            for (int bj = 0; bj < 2; ++bj) { const int col = u.pn * 256 + bj * 128 + wc * 32 + 8 * fq;
                float v[8]; ld8(bj ? a1 : a0, v); const f32x4 x0 = *(const f32x4*)(xr + col), x1 = *(const f32x4*)(xr + col + 4);
#pragma unroll
                for (int i = 0; i < 4; ++i) { v[i] += x0[i]; v[4 + i] += x1[i]; }
#pragma unroll
                for (int i = 0; i < 8; ++i) ss += v[i] * v[i];
                st8f(H + (size_t)row * DM + col, v); st8h(HH + (size_t)row * DM + col, v); } }
        ss += __shfl_xor(ss, 16); ss += __shfl_xor(ss, 32);
        if (fq == 0 && row < MR) SS[(size_t)row * 16 + u.pn * 4 + wc] = ss;
    }
    __device__ __forceinline__ void operator()(f32x4 (&acc)[2][2][4][2], const pg8::Unit& u, int wr, int wc, int fr, int fq) const { EPI_CALL_ROWS(); }
};

__device__ __forceinline__ float rstd_from_parts(const float* SS, int row) {
    const f32x4* p = (const f32x4*)(SS + (size_t)row * 16); const f32x4 a = p[0], b = p[1], c = p[2], d = p[3];
    const float s = ((a[0] + a[1]) + (a[2] + a[3])) + ((b[0] + b[1]) + (b[2] + b[3])) + ((c[0] + c[1]) + (c[2] + c[3])) + ((d[0] + d[1]) + (d[2] + d[3]));
    return 1.0f / sqrtf(s * (1.0f / DM) + RMS_EPS);
}

struct EpiGateUp {
    const float* SS; f16* ACT;
    __device__ __forceinline__ bool zero_after(const pg8::Unit&) const { return true; }
    __device__ __forceinline__ void row_op(f32x4 (&a0)[2], f32x4 (&a1)[2], int row, const pg8::Unit& u, int wc, int fq) const {
        if (row >= MR) return;
        const float rs = rstd_from_parts(SS, row);
        float g[8], up[8], a[8]; ld8(a0, g); ld8(a1, up);
#pragma unroll
        for (int i = 0; i < 8; ++i) { const float gg = g[i] * rs; a[i] = gg * (up[i] * rs) / (1.0f + __expf(-gg)); }
        st8h(ACT + (size_t)row * DFF + u.pn * 128 + wc * 32 + 8 * fq, a);
    }
    __device__ __forceinline__ void operator()(f32x4 (&acc)[2][2][4][2], const pg8::Unit& u, int wr, int wc, int fr, int fq) const { EPI_CALL_ROWS(); }
};

struct EpiDown {
    const float* H; float* out; float* SS;
    __device__ __forceinline__ bool zero_after(const pg8::Unit&) const { return true; }
    __device__ __forceinline__ void row_op(f32x4 (&a0)[2], f32x4 (&a1)[2], int row, const pg8::Unit& u, int wc, int fq) const {
        float ss = 0.f;
        if (row < MR) { float* yr = out + (row < MP ? O_Y_P + (size_t)row * DM : O_Y_S + (size_t)(row - MP) * DM);
#pragma unroll
            for (int bj = 0; bj < 2; ++bj) { const int col = u.pn * 256 + bj * 128 + wc * 32 + 8 * fq;
                float v[8]; ld8(bj ? a1 : a0, v); const f32x4 h0 = *(const f32x4*)(H + (size_t)row * DM + col), h1 = *(const f32x4*)(H + (size_t)row * DM + col + 4);
#pragma unroll
                for (int i = 0; i < 4; ++i) { v[i] += h0[i]; v[4 + i] += h1[i]; }
#pragma unroll
                for (int i = 0; i < 8; ++i) ss += v[i] * v[i];
                st8f(yr + col, v); } }
        ss += __shfl_xor(ss, 16); ss += __shfl_xor(ss, 32);
        if (fq == 0 && row < MR) SS[(size_t)row * 16 + u.pn * 4 + wc] = ss;
    }
    __device__ __forceinline__ void operator()(f32x4 (&acc)[2][2][4][2], const pg8::Unit& u, int wr, int wc, int fr, int fq) const { EPI_CALL_ROWS(); }
};

#define SG_STEP(K_) do { const half8 x_ = *(const half8*)(ap + (K_)); \
        const half8 w0_ = *(const half8*)(wp + (K_)), w1_ = *(const half8*)(wp + (size_t)4 * g.ldb + (K_)), w2_ = *(const half8*)(wp + (size_t)128 * g.ldb + (K_)), w3_ = *(const half8*)(wp + (size_t)132 * g.ldb + (K_)); \
        a[0] = __builtin_amdgcn_mfma_f32_16x16x32_f16(w0_, x_, a[0], 0, 0, 0); a[1] = __builtin_amdgcn_mfma_f32_16x16x32_f16(w1_, x_, a[1], 0, 0, 0); \
        a[2] = __builtin_amdgcn_mfma_f32_16x16x32_f16(w2_, x_, a[2], 0, 0, 0); a[3] = __builtin_amdgcn_mfma_f32_16x16x32_f16(w3_, x_, a[3], 0, 0, 0); } while (0)
template <class Epi> __device__ __forceinline__ void small_gemm_wg(LAS unsigned char* lds, const pg8::Gemm& g, const Epi& E, int tile0, int tstride, int ntiles, int nsub, int wave, int lane) {
    asm volatile("" : "+v"(lane));
    const int fr = lane & 15, fq = lane >> 4, kw = g.K / 8;
    LAS f32x4* red = (LAS f32x4*)lds;
#pragma unroll 1
    for (int t = tile0; t < ntiles; t += tstride) {
        const int m = t & 3, wc = (t >> 2) & 3, wr = (t >> 4) & 1, pn = t >> 5;
        const int row = MP + 64 * wr + 16 * m + fr;
        const f16* ap = g.A + (size_t)row * g.lda + 8 * fq;
        const f16* wp = g.Bt + (size_t)(256 * pn + 32 * wc + 8 * (fr >> 2) + (fr & 3)) * g.ldb + 8 * fq;
        pg8::Unit u; u.pm = MP / 256; u.pn = pn; u.ka = u.kb = 0; u.sub = 1;
        f32x4 tot0[2], tot1[2];
        tot0[0] = tot0[1] = tot1[0] = tot1[1] = (f32x4){0.f, 0.f, 0.f, 0.f};
#pragma unroll 1
        for (int sub = 0; sub < nsub; ++sub) {
            f32x4 a[4];
            a[0] = a[1] = a[2] = a[3] = (f32x4){0.f, 0.f, 0.f, 0.f};
            int k = sub * g.K + wave * kw; const int kend = k + kw;
#pragma unroll 1
            for (; k + 128 <= kend; k += 128) { SG_STEP(k); SG_STEP(k + 32); SG_STEP(k + 64); SG_STEP(k + 96); }
#pragma unroll 1
            for (; k < kend; k += 32) SG_STEP(k);
            if (wave > 0) {
#pragma unroll
                for (int i = 0; i < 4; ++i) red[((wave - 1) * 4 + i) * 64 + lane] = a[i]; }
            LDS_WAIT(); __syncthreads();
            if (wave == 0) {
#pragma unroll
                for (int w = 0; w < 7; ++w)
#pragma unroll
                    for (int i = 0; i < 4; ++i) a[i] += red[(w * 4 + i) * 64 + lane];
                tot0[0] += a[0]; tot0[1] += a[1]; tot1[0] += a[2]; tot1[1] += a[3];
                u.sub = nsub == 2 ? sub : 1;
                E.row_op(tot0, tot1, row, u, wc, fq);
            }
            __syncthreads();
        }
    }
}
#undef SG_STEP
constexpr int SCP_P = 8224, SCP_S = 16448, HIST_OFF = 131584, HIST_PITCH = 1040, IDXL_OFF = HIST_OFF + 16 * HIST_PITCH, IDXL_PITCH = 544, WBUF = 9216, VPITCH = 144;
static_assert(IDXL_OFF + 16 * IDXL_PITCH <= MISC_OFF && 8 * WBUF <= HIST_OFF && 16 * SCP_P <= HIST_OFF && 4 * SCP_S <= HIST_OFF, "attention LDS map");
constexpr float LOG2E = 1.4426950408889634f, LN2 = 0.6931471805599453f;

__device__ __forceinline__ f32x4 mfma16(half8 a, half8 b, f32x4 c) { return __builtin_amdgcn_mfma_f32_16x16x32_f16(a, b, c, 0, 0, 0); }
__device__ __forceinline__ f32x16 mfma32(half8 a, half8 b, f32x16 c) { return __builtin_amdgcn_mfma_f32_32x32x16_f16(a, b, c, 0, 0, 0); }
__device__ __forceinline__ half8 cvt8(f32x4 a, f32x4 b) { half8 h; h[0] = (f16)a[0]; h[1] = (f16)a[1]; h[2] = (f16)a[2]; h[3] = (f16)a[3]; h[4] = (f16)b[0]; h[5] = (f16)b[1]; h[6] = (f16)b[2]; h[7] = (f16)b[3]; return h; }
template <int OFF> __device__ __forceinline__ half4 tr_read(unsigned lds_addr) { s16x4 r; asm volatile("ds_read_b64_tr_b16 %0, %1 offset:%2\n\ts_waitcnt lgkmcnt(0)" : "=&v"(r) : "v"(lds_addr), "n"(OFF) : "memory"); return __builtin_bit_cast(half4, r); }
#define LAUNDER(x) asm volatile("" : "+v"(x))
template <int O0, int O1, int O2, int O3, int O4, int O5, int O6, int O7> __device__ __forceinline__ void tr_read8(unsigned a, half4 (&r)[8]) {
    s16x4 d0, d1, d2, d3, d4, d5, d6, d7;
    asm volatile("ds_read_b64_tr_b16 %0, %8 offset:%9\n\tds_read_b64_tr_b16 %1, %8 offset:%10\n\tds_read_b64_tr_b16 %2, %8 offset:%11\n\tds_read_b64_tr_b16 %3, %8 offset:%12\n\t"
                 "ds_read_b64_tr_b16 %4, %8 offset:%13\n\tds_read_b64_tr_b16 %5, %8 offset:%14\n\tds_read_b64_tr_b16 %6, %8 offset:%15\n\tds_read_b64_tr_b16 %7, %8 offset:%16\n\ts_waitcnt lgkmcnt(0)"
                 : "=&v"(d0), "=&v"(d1), "=&v"(d2), "=&v"(d3), "=&v"(d4), "=&v"(d5), "=&v"(d6), "=&v"(d7)
                 : "v"(a), "n"(O0), "n"(O1), "n"(O2), "n"(O3), "n"(O4), "n"(O5), "n"(O6), "n"(O7) : "memory");
    r[0] = __builtin_bit_cast(half4, d0); r[1] = __builtin_bit_cast(half4, d1); r[2] = __builtin_bit_cast(half4, d2); r[3] = __builtin_bit_cast(half4, d3);
    r[4] = __builtin_bit_cast(half4, d4); r[5] = __builtin_bit_cast(half4, d5); r[6] = __builtin_bit_cast(half4, d6); r[7] = __builtin_bit_cast(half4, d7);
}
__device__ __forceinline__ half8 cat4(half4 lo, half4 hi) { return __builtin_shufflevector(lo, hi, 0, 1, 2, 3, 4, 5, 6, 7); }
__device__ __forceinline__ unsigned lds_addr_of(LAS const void* p) { return (unsigned)(size_t)p; }
__device__ __forceinline__ unsigned tokey(unsigned h) { return (h & 0x8000u) ? (~h & 0xFFFFu) : (h | 0x8000u); }

__device__ __forceinline__ void find_bin(LAS unsigned* hist, unsigned need, int lane, unsigned& bin, unsigned& above) {
    const u32x4 c = *(LAS u32x4*)(hist + 4 * lane);
    const unsigned s = c.x + c.y + c.z + c.w; unsigned S = s;
#pragma unroll
    for (int off = 1; off < 64; off <<= 1) { const unsigned t = __shfl_down(S, off); if (lane + off < 64) S += t; }
    const unsigned ab = S - s;
    const unsigned long long mk = __ballot((ab < need) && (S >= need));
    const int L = mk ? __ffsll((long long)mk) - 1 : 0;
    unsigned cum = ab, b = 4 * lane, a = ab; bool found = false;
#pragma unroll
    for (int e = 3; e >= 0; --e) { const unsigned ce = c[e]; if (!found && cum + ce >= need) { b = 4 * lane + e; a = cum; found = true; } cum += ce; }
    bin = __shfl(b, L); above = __shfl(a, L);
}
template <bool MASKOUT> __device__ __forceinline__ int topk_select(LAS const unsigned short* row, int n, LAS unsigned* hist, LAS unsigned short* idxo, unsigned char* maskb, int lane) {
    LAUNDER(lane);
    if (n <= TOPK) {
        if (MASKOUT) { const int rem = n - 8 * lane; maskb[lane] = (unsigned char)(rem >= 8 ? 0xFFu : (rem > 0 ? (1u << rem) - 1u : 0u)); return n; }
        for (int i = lane; i < n; i += 64) idxo[i] = (unsigned short)i; LDS_WAIT(); return n; }
    unsigned B1 = 0, ab1 = 0, B2 = 0, ab2 = 0;
    find_bin(hist, (unsigned)TOPK, lane, B1, ab1);
    LDS_WAIT(); asm volatile("" ::: "memory");
    *(LAS u32x4*)(hist + 4 * lane) = (u32x4){0u, 0u, 0u, 0u};
    LDS_WAIT(); asm volatile("" ::: "memory");
#pragma unroll 1
    for (int base = 0; base < n; base += 512) { const int i0 = base + 8 * lane;
        if (i0 < n) { const u32x4 v = *(LAS const u32x4*)(row + i0);
#pragma unroll
            for (int e = 0; e < 8; ++e) { const unsigned k = (v[e >> 1] >> (16 * (e & 1))) & 0xFFFFu;
                if ((k >> 8) == B1) __hip_atomic_fetch_add(hist + (k & 255u), 1u, __ATOMIC_RELAXED, __HIP_MEMORY_SCOPE_WORKGROUP); } } }
    LDS_WAIT(); asm volatile("" ::: "memory");
    find_bin(hist, (unsigned)TOPK - ab1, lane, B2, ab2);
    LDS_WAIT(); asm volatile("" ::: "memory");
    const unsigned T = (B1 << 8) | B2, r2 = (unsigned)TOPK - ab1 - ab2;
    int pos = 0; unsigned ties = 0;
#define WPREFIX(cnt, excl, total) do { unsigned e_ = 0, t_ = 0; _Pragma("unroll") for (int b_ = 0; b_ < 4; ++b_) { const unsigned long long m_ = __ballot(((cnt) >> b_) & 1u); \
        e_ += __builtin_amdgcn_mbcnt_hi((unsigned)(m_ >> 32), __builtin_amdgcn_mbcnt_lo((unsigned)m_, 0u)) << b_; t_ += (unsigned)__popcll(m_) << b_; } (excl) = e_; (total) = t_; } while (0)
#pragma unroll 1
    for (int base = 0; base < n; base += 512) { const int i0 = base + 8 * lane;
        u32x4 v = (u32x4){0u, 0u, 0u, 0u}; if (i0 < n) v = *(LAS const u32x4*)(row + i0);
        unsigned gtm = 0, eqm = 0;
#pragma unroll
        for (int e = 0; e < 8; ++e) { const unsigned k = (v[e >> 1] >> (16 * (e & 1))) & 0xFFFFu; gtm |= (k > T) ? (1u << e) : 0u; eqm |= (k == T) ? (1u << e) : 0u; }
        unsigned selm = gtm;
        if (__ballot(eqm != 0u)) { unsigned ex, tot; const unsigned ce = (unsigned)__popc(eqm); WPREFIX(ce, ex, tot);
            unsigned tb = ties + ex;
#pragma unroll
            for (int e = 0; e < 8; ++e) if ((eqm >> e) & 1u) { if (tb < r2) selm |= 1u << e; ++tb; }
            ties += tot; }
        if (MASKOUT) { maskb[i0 >> 3] = (unsigned char)selm; }
        else { unsigned ex, tot; const unsigned cs = (unsigned)__popc(selm); WPREFIX(cs, ex, tot);
            int p = pos + (int)ex;
#pragma unroll
            for (int e = 0; e < 8; ++e) if ((selm >> e) & 1u) { idxo[p] = (unsigned short)(i0 + e); ++p; }
            pos += (int)tot; } }
#undef WPREFIX
    LDS_WAIT();
    return pos;
}

struct KvSrc {
    const f16 *KA, *VA; const float *cache, *newrows; const int* pt; int rowbase;
};
template <bool SAMPLE> struct KvFrag;
template <> struct KvFrag<false> {
    half8 v;
    __device__ __forceinline__ void load(const KvSrc& S, int key, int kv, int off) { v = *(const half8*)((kv ? S.VA : S.KA) + (size_t)(S.rowbase + key) * 128 + off); }
    __device__ __forceinline__ half8 get() const { return v; }
};
template <> struct KvFrag<true> {
    f32x4 a, b;
    __device__ __forceinline__ void load(const KvSrc& S, int key, int kv, int off) {
        const int kc = key < PAST ? key : PAST - 1;
        const float* p = (key < PAST ? S.cache + ((size_t)S.pt[kc >> 7] * PAGE + (kc & (PAGE - 1))) * 256 : S.newrows + (size_t)(key - PAST) * 256) + kv * 128 + off;
        a = *(const f32x4*)p; b = *(const f32x4*)(p + 4); }
    __device__ __forceinline__ half8 get() const { return cvt8(a, b); }
};
template <bool SAMPLE> __device__ __forceinline__ void dsa_pair(const KvSrc& S, LAS const unsigned short* idx, int cnt, const f16* QA, int qrow, int c, LAS unsigned char* vbuf, f16* OAB, int lane, bool fake = false) {
    LAUNDER(lane);
    const int fr = lane & 15, fq = lane >> 4;
    half8 B0, B1;
#pragma unroll
    for (int i = 0; i < 8; ++i) { B0[i] = (f16)0.f; B1[i] = (f16)0.f; }
    if (fr < 4) { const f16* q = QA + (size_t)qrow * 512 + (4 * c + fr) * 64; B0 = *(const half8*)(q + 8 * fq); B1 = *(const half8*)(q + 32 + 8 * fq); }
    f32x4 s[16];
    constexpr int GBK = SAMPLE ? 4 : 16;
#pragma unroll
    for (int gb = 0; gb < 16; gb += GBK) {
        KvFrag<SAMPLE> A[GBK][2];
#pragma unroll
        for (int j = 0; j < GBK; ++j) { const int slot = 16 * (gb + j) + fr, key = fake ? (slot & 15) : idx[slot < cnt ? slot : cnt - 1];
            A[j][0].load(S, key, 0, c * 64 + 8 * fq); A[j][1].load(S, key, 0, c * 64 + 32 + 8 * fq); }
#pragma unroll
        for (int j = 0; j < GBK; ++j) { s[gb + j] = mfma16(A[j][0].get(), B0, (f32x4){0.f, 0.f, 0.f, 0.f}); s[gb + j] = mfma16(A[j][1].get(), B1, s[gb + j]); }
    }
    constexpr int NVB = SAMPLE ? 1 : 4;
    KvFrag<SAMPLE> Vr[NVB][8];
    if (!SAMPLE) {
#pragma unroll
        for (int ch = 0; ch < 4; ++ch)
#pragma unroll
            for (int i = 0; i < 8; ++i) { const int slot = 64 * ch + (lane >> 3) + 8 * i, key = fake ? (slot & 15) : idx[slot < cnt ? slot : cnt - 1]; Vr[ch % NVB][i].load(S, key, 1, c * 64 + 8 * (lane & 7)); }
        asm volatile("" ::: "memory");
    }
    float mx = -INFINITY;
#pragma unroll
    for (int g = 0; g < 16; ++g)
#pragma unroll
        for (int e = 0; e < 4; ++e) { const float v = (16 * g + 4 * fq + e < cnt) ? s[g][e] * (0.125f * LOG2E) : -INFINITY; s[g][e] = v; mx = fmaxf(mx, v); }
    mx = fmaxf(mx, __shfl_xor(mx, 16)); mx = fmaxf(mx, __shfl_xor(mx, 32));
    float l = 0.f;
#pragma unroll
    for (int g = 0; g < 16; ++g)
#pragma unroll
        for (int e = 0; e < 4; ++e) { const float p = __builtin_amdgcn_exp2f(s[g][e] - mx); s[g][e] = p; l += p; }
    l += __shfl_xor(l, 16); l += __shfl_xor(l, 32);
    f32x4 o[4];
#pragma unroll
    for (int dt = 0; dt < 4; ++dt) o[dt] = (f32x4){0.f, 0.f, 0.f, 0.f};
    const unsigned vb = lds_addr_of(vbuf) + (unsigned)((4 * fq + (fr >> 2)) * VPITCH + (fr & 3) * 8);
    LAS unsigned char* vw = vbuf + (lane >> 3) * VPITCH + (lane & 7) * 16;
#pragma unroll
    for (int ch = 0; ch < 4; ++ch) {
        if (SAMPLE) {
#pragma unroll
            for (int i = 0; i < 8; ++i) { const int slot = 64 * ch + (lane >> 3) + 8 * i, key = idx[slot < cnt ? slot : cnt - 1]; Vr[0][i].load(S, key, 1, c * 64 + 8 * (lane & 7)); }
        }
#pragma unroll
        for (int i = 0; i < 8; ++i) *(LAS half8*)(vw + 8 * i * VPITCH) = Vr[ch % NVB][i].get();
        LDS_WAIT(); asm volatile("" ::: "memory");
#pragma unroll
        for (int ksl = 0; ksl < 2; ++ksl) { const int ks = 2 * ch + ksl;
            half8 pf;
#pragma unroll
            for (int j = 0; j < 4; ++j) { pf[j] = (f16)s[2 * ks][j]; pf[4 + j] = (f16)s[2 * ks + 1][j]; }
            half4 t[8];
            if (ksl) tr_read8<32 * VPITCH, 48 * VPITCH, 32 * VPITCH + 32, 48 * VPITCH + 32, 32 * VPITCH + 64, 48 * VPITCH + 64, 32 * VPITCH + 96, 48 * VPITCH + 96>(vb, t);
            else     tr_read8<0, 16 * VPITCH, 32, 16 * VPITCH + 32, 64, 16 * VPITCH + 64, 96, 16 * VPITCH + 96>(vb, t);
#pragma unroll
            for (int dt = 0; dt < 4; ++dt) o[dt] = mfma16(cat4(t[2 * dt], t[2 * dt + 1]), pf, o[dt]);
        }
        asm volatile("" ::: "memory");
    }
    if (fr < 4 && !fake) { const float il = 1.0f / l; f16* op = OAB + (size_t)qrow * 1024 + (4 * c + fr) * 64 + 4 * fq;
#pragma unroll
        for (int dt = 0; dt < 4; ++dt) *(u32x2*)(op + 16 * dt) = (u32x2){pkh(o[dt][0] * il, o[dt][1] * il), pkh(o[dt][2] * il, o[dt][3] * il)}; }
}

template <bool SAMPLE> __device__ __forceinline__ void idx_unit(const Frame& F, const Params& P, int bs, int tt, int smask = 7) {
    unsigned char* ws = P.ws;
    int lane = F.lane; LAUNDER(lane);
    const int wave = F.wave, fr = lane & 15, fq = lane >> 4;
    const f16* QI = (const f16*)(ws + WS_QI); const f16* KI = (const f16*)(ws + WS_KI); const float* WI = (const float*)(ws + WS_WI);
    const int t0 = SAMPLE ? 0 : 16 * tt, rowbase = SAMPLE ? MP + 4 * bs : bs * SEQ;
    const int qrow_l = SAMPLE ? rowbase + (fr < 4 ? fr : 3) : rowbase + t0 + fr;
    constexpr int SCP = SAMPLE ? SCP_S : SCP_P;
    for (int i = F.tid; i < 16 * HIST_PITCH / 4; i += NWAVES * 64) ((LAS unsigned*)(F.lds + HIST_OFF))[i] = 0u;
    if (!SAMPLE) {
        const int nk = 16 * (tt + 1), ne = ((nk + 511) & ~511) - nk;
        for (int i = F.tid; i < 16 * (ne / 8); i += NWAVES * 64) { const int q = i / (ne / 8), c8 = i % (ne / 8); *(LAS u32x4*)(F.lds + q * SCP + (nk + 8 * c8) * 2) = (u32x4){0u, 0u, 0u, 0u}; }
    }
    LDS_WAIT(); __syncthreads();
    {
        half8 Bq[8][2], Qh[2], Ql[2]; float w[8];
        {   float qt[2][8];
#pragma unroll
            for (int i = 0; i < 8; ++i) { qt[0][i] = 0.f; qt[1][i] = 0.f; }
#pragma unroll
            for (int h = 0; h < 8; ++h) { const f16* q = QI + (size_t)qrow_l * 512 + h * 64; Bq[h][0] = *(const half8*)(q + 8 * fq); Bq[h][1] = *(const half8*)(q + 32 + 8 * fq); w[h] = WI[(size_t)qrow_l * 8 + h] * 0.0625f;
#pragma unroll
                for (int i = 0; i < 8; ++i) { qt[0][i] = fmaf(w[h], (float)Bq[h][0][i], qt[0][i]); qt[1][i] = fmaf(w[h], (float)Bq[h][1][i], qt[1][i]); } }
#pragma unroll
            for (int ks = 0; ks < 2; ++ks)
#pragma unroll
                for (int i = 0; i < 8; ++i) { const f16 hi = (f16)qt[ks][i]; Qh[ks][i] = hi; Ql[ks][i] = (f16)(qt[ks][i] - (float)hi); } }
        const int ng = SAMPLE ? (PAST / 16 + 1) : tt + 1, nit = (ng + 4 * NWAVES - 1) / (4 * NWAVES);
        const int* pt = P.pt + bs * NPAGES;
        const float* newki = P.out + O_KI_S + (size_t)bs * (DECS * 64);
        const int qp = SAMPLE ? PAST + fr : t0 + fr;
        LAS unsigned* hq = (LAS unsigned*)(F.lds + HIST_OFF + fr * HIST_PITCH);
        half8 Ah[2][4][2]; f32x4 Af[1][4][4];
#define IDX_LOAD(SET, IT) do { const int g0_ = 4 * (wave + NWAVES * (IT)); _Pragma("unroll") for (int j = 0; j < 4; ++j) { const int g = (g0_ + j < ng) ? g0_ + j : ng - 1; \
            if (SAMPLE) { const int key = 16 * g + fr, kc = key < PAST ? key : PAST - 1, kn = key - PAST; \
                const float* p_ = (key < PAST ? P.c_ki + ((size_t)pt[kc >> 7] * PAGE + (kc & (PAGE - 1))) * 64 : newki + (kn < DECS ? kn : DECS - 1) * 64) + 8 * fq; \
                Af[SET][j][0] = *(const f32x4*)p_; Af[SET][j][1] = *(const f32x4*)(p_ + 4); Af[SET][j][2] = *(const f32x4*)(p_ + 32); Af[SET][j][3] = *(const f32x4*)(p_ + 36); } \
            else { const f16* k_ = KI + (size_t)(rowbase + 16 * g + fr) * 64 + 8 * fq; Ah[SET][j][0] = *(const half8*)k_; Ah[SET][j][1] = *(const half8*)(k_ + 32); } } } while (0)
#define IDX_COMPUTE(SET, IT) do { const int g0_ = 4 * (wave + NWAVES * (IT)); _Pragma("unroll") for (int j = 0; j < 4; ++j) { \
            const half8 A0 = SAMPLE ? cvt8(Af[SET][j][0], Af[SET][j][1]) : Ah[SET][j][0], A1 = SAMPLE ? cvt8(Af[SET][j][2], Af[SET][j][3]) : Ah[SET][j][1]; \
            f32x4 sc = mfma16(A0, Qh[0], (f32x4){0.f, 0.f, 0.f, 0.f}); sc = mfma16(A1, Qh[1], sc); sc = mfma16(A0, Ql[0], sc); sc = mfma16(A1, Ql[1], sc); \
            f32x4 sv[8]; \
            _Pragma("unroll") for (int h = 0; h < 8; ++h) sv[h] = mfma16(A0, Bq[h][0], (f32x4){0.f, 0.f, 0.f, 0.f}); \
            _Pragma("unroll") for (int h = 0; h < 8; ++h) sv[h] = mfma16(A1, Bq[h][1], sv[h]); \
            _Pragma("unroll") for (int h = 0; h < 8; ++h) { _Pragma("unroll") for (int e = 0; e < 4; ++e) sc[e] = fmaf(w[h], __builtin_fabsf(sv[h][e]), sc[e]); } \
            const int g = g0_ + j; \
            if (g < ng && (!SAMPLE || fr < 4)) { unsigned w0 = pkh(sc[0], sc[1]), w1 = pkh(sc[2], sc[3]); \
                w0 ^= (((w0 & 0x80008000u) >> 15) * 0x7FFFu) | 0x80008000u; w1 ^= (((w1 & 0x80008000u) >> 15) * 0x7FFFu) | 0x80008000u;     \
                const int kb = 16 * g + 4 * fq; \
                if (g < ng - 1) { \
                    __hip_atomic_fetch_add(hq + ((w0 >> 8) & 255u), 1u, __ATOMIC_RELAXED, __HIP_MEMORY_SCOPE_WORKGROUP); __hip_atomic_fetch_add(hq + (w0 >> 24), 1u, __ATOMIC_RELAXED, __HIP_MEMORY_SCOPE_WORKGROUP); \
                    __hip_atomic_fetch_add(hq + ((w1 >> 8) & 255u), 1u, __ATOMIC_RELAXED, __HIP_MEMORY_SCOPE_WORKGROUP); __hip_atomic_fetch_add(hq + (w1 >> 24), 1u, __ATOMIC_RELAXED, __HIP_MEMORY_SCOPE_WORKGROUP); \
                } else {              \
                    if (kb + 0 <= qp) __hip_atomic_fetch_add(hq + ((w0 >> 8) & 255u), 1u, __ATOMIC_RELAXED, __HIP_MEMORY_SCOPE_WORKGROUP); else w0 &= 0xFFFF0000u; \
                    if (kb + 1 <= qp) __hip_atomic_fetch_add(hq + (w0 >> 24), 1u, __ATOMIC_RELAXED, __HIP_MEMORY_SCOPE_WORKGROUP); else w0 &= 0x0000FFFFu; \
                    if (kb + 2 <= qp) __hip_atomic_fetch_add(hq + ((w1 >> 8) & 255u), 1u, __ATOMIC_RELAXED, __HIP_MEMORY_SCOPE_WORKGROUP); else w1 &= 0xFFFF0000u; \
                    if (kb + 3 <= qp) __hip_atomic_fetch_add(hq + (w1 >> 24), 1u, __ATOMIC_RELAXED, __HIP_MEMORY_SCOPE_WORKGROUP); else w1 &= 0x0000FFFFu; } \
                *(LAS u32x2*)(F.lds + fr * SCP + kb * 2) = (u32x2){w0, w1}; } } } while (0)
        if (SAMPLE) {
#pragma unroll 1
            for (int it = 0; it < nit; ++it) { IDX_LOAD(0, it); IDX_COMPUTE(0, it); }
        } else {
            IDX_LOAD(0, 0);
#pragma unroll 1
            for (int it = 0; it < nit; it += 2) {
                if (it + 1 < nit) IDX_LOAD(1, it + 1);
                IDX_COMPUTE(0, it);
                if (it + 1 < nit) { if (it + 2 < nit) IDX_LOAD(0, it + 2); IDX_COMPUTE(1, it + 1); }
            }
        }
#undef IDX_LOAD
#undef IDX_COMPUTE
    }
    LDS_WAIT(); __syncthreads();
    if (!(smask & 2)) return;
#pragma unroll 1
    for (int qi = wave; qi < (SAMPLE ? 4 : 16); qi += NWAVES) {
        LAS unsigned short* io = (LAS unsigned short*)(F.lds + IDXL_OFF + qi * IDXL_PITCH);
        const int n = SAMPLE ? PAST + qi + 1 : t0 + qi + 1;
        const int cnt = topk_select<!SAMPLE>((LAS const unsigned short*)(F.lds + qi * SCP), n, (LAS unsigned*)(F.lds + HIST_OFF + qi * HIST_PITCH), io, ws + WS_MASK + (size_t)(rowbase + t0 + qi) * 512, lane);
        if (lane == 0) io[256] = (unsigned short)cnt;
    }
    if (!SAMPLE) return;
    LDS_WAIT(); __syncthreads();
    if (!(smask & 4)) return;
    KvSrc S; S.KA = (const f16*)(ws + WS_KA); S.VA = (const f16*)(ws + WS_VA); S.cache = P.c_kva; S.newrows = P.out + O_KVA_S + (size_t)bs * (DECS * 256); S.pt = P.pt + bs * NPAGES; S.rowbase = rowbase;
#pragma unroll 1
    for (int p = wave; p < 8; p += NWAVES) { const int qi = p >> 1, c = p & 1;
        LAS const unsigned short* io = (LAS const unsigned short*)(F.lds + IDXL_OFF + qi * IDXL_PITCH);
        const int cnt = io[256];
        dsa_pair<true>(S, io, cnt, (const f16*)(ws + WS_QA), rowbase + t0 + qi, c, F.lds + wave * WBUF, (f16*)(ws + WS_OAB), lane, (smask & 8) != 0);
    }
}

__device__ __forceinline__ int crow(int reg, int h) { return (reg & 3) + 8 * (reg >> 2) + 4 * h; }
template <bool SAMPLE> __device__ __forceinline__ void sb_item(const Params& P, int bs, int h, int qt, LAS unsigned char* buf, int lane) {
    unsigned char* ws = P.ws;
    const f16* QB = (const f16*)(ws + WS_QB); const f16* KB = (const f16*)(ws + WS_KB); const f16* VB = (const f16*)(ws + WS_VB);
    LAUNDER(lane);
    const int r = lane & 31, h2 = lane >> 5;
    const int qpos = SAMPLE ? PAST + (r < 4 ? r : 3) : 32 * qt + r;
    const int qrow = SAMPLE ? MP + 4 * bs + (r < 4 ? r : 3) : bs * SEQ + qpos;
    half8 Bq[4];
#pragma unroll
    for (int ks = 0; ks < 4; ++ks) Bq[ks] = *(const half8*)(QB + (size_t)qrow * 512 + h * 64 + 16 * ks + 8 * h2);
    f32x16 O0, O1;
#pragma unroll
    for (int i = 0; i < 16; ++i) { O0[i] = 0.f; O1[i] = 0.f; }
    float carry = 0.f;
    LAS unsigned char* kb = buf; LAS unsigned char* vbp = buf + 32 * VPITCH;
    const unsigned vb = lds_addr_of(vbp) + (unsigned)((4 * h2 + ((lane & 15) >> 2)) * VPITCH + (16 * ((lane >> 4) & 1) + 4 * (lane & 3)) * 2);
    const int* pt = P.pt + bs * NPAGES;
    half8 Kh[4], Vh[4]; f32x4 Kf[8], Vf[8];
    const float* newkvb = P.out + O_KVB_S + (size_t)bs * (DECS * 1024);
#define SB_LOAD_TILE(T) do { const int p0_ = 32 * (T); \
        if (SAMPLE) { const size_t ri0 = (T) < PAST / 32 ? (size_t)pt[p0_ >> 7] * PAGE + (p0_ & (PAGE - 1)) : 0; \
            _Pragma("unroll") for (int i = 0; i < 8; ++i) { const int id = lane + 64 * i, kk = id >> 4, cc = id & 15; \
                const float* kp = ((T) < PAST / 32 ? P.c_kvb + (ri0 + kk) * 1024 : newkvb + (kk < DECS ? kk : DECS - 1) * 1024) + h * 64 + 4 * cc; Kf[i] = *(const f32x4*)kp; Vf[i] = *(const f32x4*)(kp + 512); } } \
        else { _Pragma("unroll") for (int i = 0; i < 4; ++i) { const int id = lane + 64 * i, kk = id >> 3, cc = id & 7; const size_t ro = (size_t)(bs * SEQ + p0_ + kk) * 512 + h * 64 + 8 * cc; \
                Kh[i] = *(const half8*)(KB + ro); Vh[i] = *(const half8*)(VB + ro); } } } while (0)
    SB_LOAD_TILE(SAMPLE ? PAST / 32 : qt);
#pragma unroll 1
    for (int tile = SAMPLE ? PAST / 32 : qt; tile >= 0; --tile) {
        const int p0 = 32 * tile;
        if (SAMPLE) {
#pragma unroll
            for (int i = 0; i < 8; ++i) { const int id = lane + 64 * i, kk = id >> 4, cc = id & 15;
                *(LAS u32x2*)(kb + kk * VPITCH + cc * 8) = (u32x2){pkh(Kf[i][0], Kf[i][1]), pkh(Kf[i][2], Kf[i][3])};
                *(LAS u32x2*)(vbp + kk * VPITCH + cc * 8) = (u32x2){pkh(Vf[i][0], Vf[i][1]), pkh(Vf[i][2], Vf[i][3])}; }
        } else {
#pragma unroll
            for (int i = 0; i < 4; ++i) { const int id = lane + 64 * i, kk = id >> 3, cc = id & 7;
                *(LAS half8*)(kb + kk * VPITCH + cc * 16) = Kh[i]; *(LAS half8*)(vbp + kk * VPITCH + cc * 16) = Vh[i]; }
        }
        if (tile > 0) SB_LOAD_TILE(tile - 1);
        LDS_WAIT(); asm volatile("" ::: "memory");
        f32x16 s;
#pragma unroll
        for (int i = 0; i < 16; ++i) s[i] = 0.f;
#pragma unroll
        for (int ks = 0; ks < 4; ++ks) s = mfma32(*(LAS const half8*)(kb + r * VPITCH + (16 * ks + 8 * h2) * 2), Bq[ks], s);
        float sp[16], gs[4], pg[4];
#pragma unroll
        for (int i = 0; i < 16; ++i) { const float z = s[i] * 0.125f; const bool valid = p0 + crow(i, h2) < qpos;
            const float e = __builtin_amdgcn_exp2f(-fabsf(z) * LOG2E);
            const float v = fmaxf(z, 0.f) + __builtin_amdgcn_logf(1.0f + e) * LN2;
            sp[i] = valid ? v : 0.f; s[i] = valid ? z : -INFINITY; }
#pragma unroll
        for (int gi = 0; gi < 4; ++gi) { gs[gi] = (sp[4 * gi] + sp[4 * gi + 1]) + (sp[4 * gi + 2] + sp[4 * gi + 3]); pg[gi] = __shfl_xor(gs[gi], 32); }
        float base = carry;
        float a[16];
#pragma unroll
        for (int gi = 3; gi >= 0; --gi) { float c = base + (h2 == 0 ? pg[gi] : 0.f);
#pragma unroll
            for (int e = 3; e >= 0; --e) { c += sp[4 * gi + e]; a[4 * gi + e] = __builtin_amdgcn_exp2f((s[4 * gi + e] - c) * LOG2E); }
            base += gs[gi] + pg[gi]; }
        carry = base;
        half4 vt[8];
        tr_read8<0, 8 * VPITCH, 64, 8 * VPITCH + 64, 16 * VPITCH, 24 * VPITCH, 16 * VPITCH + 64, 24 * VPITCH + 64>(vb, vt);
#pragma unroll
        for (int s2 = 0; s2 < 2; ++s2) { half8 pf;
#pragma unroll
            for (int j = 0; j < 8; ++j) pf[j] = (f16)a[8 * s2 + j];
            O0 = mfma32(cat4(vt[4 * s2], vt[4 * s2 + 1]), pf, O0); O1 = mfma32(cat4(vt[4 * s2 + 2], vt[4 * s2 + 3]), pf, O1); }
        asm volatile("" ::: "memory");
        if (__all(carry >= 104.0f)) break;
    }
    if (!SAMPLE || r < 4) { f16* op = (f16*)(ws + WS_OAB) + (size_t)qrow * 1024 + 512 + h * 64 + 4 * h2;
#pragma unroll
        for (int gi = 0; gi < 4; ++gi) {
            *(u32x2*)(op + 8 * gi) = (u32x2){pkh(O0[4 * gi], O0[4 * gi + 1]), pkh(O0[4 * gi + 2], O0[4 * gi + 3])};
            *(u32x2*)(op + 32 + 8 * gi) = (u32x2){pkh(O1[4 * gi], O1[4 * gi + 1]), pkh(O1[4 * gi + 2], O1[4 * gi + 3])}; } }
}

#undef SB_LOAD_TILE
constexpr int DK_TILE = 64 * VPITCH;
__device__ __forceinline__ void dsa_dense_unit(const Frame& F, const Params& P, int b, int qt, int c) {
    unsigned char* ws = P.ws;
    int lane = F.lane; LAUNDER(lane);
    const int wave = F.wave, r = lane & 31, h2 = lane >> 5, tid = F.tid;
    const f16* KA = (const f16*)(ws + WS_KA); const f16* VA = (const f16*)(ws + WS_VA);
    const int qrow = b * SEQ + 64 * qt + 8 * wave + (r >> 2), head = 4 * c + (r & 3);
    half8 Bq[4];
#pragma unroll
    for (int ks = 0; ks < 4; ++ks) Bq[ks] = *(const half8*)((const f16*)(ws + WS_QA) + (size_t)qrow * 512 + head * 64 + 16 * ks + 8 * h2);
    const unsigned* mrow = (const unsigned*)(ws + WS_MASK) + (size_t)qrow * 128;
    f32x16 O0, O1;
#pragma unroll
    for (int i = 0; i < 16; ++i) { O0[i] = 0.f; O1[i] = 0.f; }
    float l = 0.f, m = -1.0e30f;
    const int nkt = qt + 1;
    LAS unsigned char* kt0 = F.lds;
    const int lrow = tid >> 3, lpc = tid & 7;
    const size_t gsrc = (size_t)(b * SEQ + lrow) * 128 + c * 64 + 8 * lpc;
    LAS unsigned char* ldst = F.lds + lrow * VPITCH + lpc * 16;
    half8 kreg = *(const half8*)(KA + gsrc), vreg = *(const half8*)(VA + gsrc);
    *(LAS half8*)ldst = kreg; *(LAS half8*)(ldst + 2 * DK_TILE) = vreg;
    unsigned mw0 = mrow[0], mw1 = mrow[1];
    const unsigned vb0 = lds_addr_of(F.lds + 2 * DK_TILE) + (unsigned)((4 * h2 + ((lane & 15) >> 2)) * VPITCH + (16 * ((lane >> 4) & 1) + 4 * (lane & 3)) * 2);
#pragma unroll 1
    for (int kt = 0; kt < nkt; ++kt) {
        const int buf = kt & 1;
        unsigned nw0 = 0, nw1 = 0;
        if (kt + 1 < nkt) { kreg = *(const half8*)(KA + gsrc + (size_t)(64 * (kt + 1)) * 128); vreg = *(const half8*)(VA + gsrc + (size_t)(64 * (kt + 1)) * 128); nw0 = mrow[2 * kt + 2]; nw1 = mrow[2 * kt + 3]; }
        LDS_WAIT(); __syncthreads();
        f32x16 s0, s1;
#pragma unroll
        for (int i = 0; i < 16; ++i) { s0[i] = 0.f; s1[i] = 0.f; }
        { const LAS unsigned char* kb = kt0 + buf * DK_TILE + r * VPITCH + 16 * h2;
#pragma unroll
          for (int ks = 0; ks < 4; ++ks) s0 = mfma32(*(const LAS half8*)(kb + 32 * ks), Bq[ks], s0);
#pragma unroll
          for (int ks = 0; ks < 4; ++ks) s1 = mfma32(*(const LAS half8*)(kb + 32 * VPITCH + 32 * ks), Bq[ks], s1); }
        half4 vt0[8], vt1[8];
        { const unsigned vb = vb0 + (unsigned)(buf * DK_TILE);
          tr_read8<0, 8 * VPITCH, 64, 8 * VPITCH + 64, 16 * VPITCH, 24 * VPITCH, 16 * VPITCH + 64, 24 * VPITCH + 64>(vb, vt0);
          tr_read8<32 * VPITCH, 40 * VPITCH, 32 * VPITCH + 64, 40 * VPITCH + 64, 48 * VPITCH, 56 * VPITCH, 48 * VPITCH + 64, 56 * VPITCH + 64>(vb, vt1); }
#define DD_HALF(S_, W_, VT_) do { \
            float smax = fmaxf(fmaxf(S_[0], S_[1]), fmaxf(S_[2], S_[3])); \
            _Pragma("unroll") for (int i = 4; i < 16; i += 4) smax = fmaxf(smax, fmaxf(fmaxf(S_[i], S_[i + 1]), fmaxf(S_[i + 2], S_[i + 3]))); \
            smax *= (0.125f * LOG2E); smax = fmaxf(smax, __shfl_xor(smax, 32));        \
            if (__any(smax > m + 10.0f)) { const float mn = smax > m + 10.0f ? smax : m, al_ = __builtin_amdgcn_exp2f(m - mn); \
                _Pragma("unroll") for (int i = 0; i < 16; ++i) { O0[i] *= al_; O1[i] *= al_; } \
                l *= al_; m = mn; } \
            const int w_ = (int)((W_) >> (4 * h2)); float a[16]; \
            _Pragma("unroll") for (int i = 0; i < 16; ++i) { const float p_ = __builtin_amdgcn_exp2f(fmaf(S_[i], 0.125f * LOG2E, -m)); \
                a[i] = __uint_as_float(__float_as_uint(p_) & (unsigned)__builtin_amdgcn_sbfe(w_, (i & 3) + 8 * (i >> 2), 1)); l += a[i]; } \
            _Pragma("unroll") for (int s2 = 0; s2 < 2; ++s2) { half8 pf; \
                _Pragma("unroll") for (int j = 0; j < 8; ++j) pf[j] = (f16)a[8 * s2 + j]; \
                O0 = mfma32(cat4(VT_[4 * s2], VT_[4 * s2 + 1]), pf, O0); O1 = mfma32(cat4(VT_[4 * s2 + 2], VT_[4 * s2 + 3]), pf, O1); } } while (0)
        DD_HALF(s0, mw0, vt0);
        DD_HALF(s1, mw1, vt1);
#undef DD_HALF
        if (kt + 1 < nkt) { LAS unsigned char* d = ldst + (buf ^ 1) * DK_TILE; *(LAS half8*)d = kreg; *(LAS half8*)(d + 2 * DK_TILE) = vreg; mw0 = nw0; mw1 = nw1; }
    }
    l += __shfl_xor(l, 32);
    const float il = 1.0f / l;
    f16* op = (f16*)(ws + WS_OAB) + (size_t)qrow * 1024 + head * 64 + 4 * h2;
#pragma unroll
    for (int gi = 0; gi < 4; ++gi) {
        *(u32x2*)(op + 8 * gi) = (u32x2){pkh(O0[4 * gi] * il, O0[4 * gi + 1] * il), pkh(O0[4 * gi + 2] * il, O0[4 * gi + 3] * il)};
        *(u32x2*)(op + 32 + 8 * gi) = (u32x2){pkh(O1[4 * gi] * il, O1[4 * gi + 1] * il), pkh(O1[4 * gi + 2] * il, O1[4 * gi + 3] * il)}; }
}

constexpr int NU_SAMPLE = 2 * DECB, NU_PB_IDX = SEQ / 16, NU_PB_DSA = 2 * (SEQ / 64), NU_PB_SB = SEQ / 32;
template <int PART> __device__ __forceinline__ void p2_attention(const Frame& F, const Params& P, int qword, int tmask = 127) {
    const int hb = (int)(xb_xcc_id() & 3u);
    constexpr int NPB = PART == 0 ? NU_PB_IDX : NU_PB_DSA + NU_PB_SB;
    unsigned dead = PART == 0 ? 0u : 16u;
    for (;;) {
        __syncthreads();
        if (F.tid == 0) { int u = -1;
            if (!(dead & 16u)) { const unsigned t = __hip_atomic_fetch_add(F.ctl + qword + 64 * 4, 1u, RLX_AGENT); if (t < (unsigned)NU_SAMPLE) u = (int)t; else dead |= 16u; }
            for (int k = 0; k < NB && u < 0; ++k) { const int b = (hb + k) & 3;
                if (!(dead & (1u << b))) { const unsigned t = __hip_atomic_fetch_add(F.ctl + qword + 64 * b, 1u, RLX_AGENT); if (t < (unsigned)NPB) u = NU_SAMPLE + b * NPB + (int)t; else dead |= 1u << b; } }
            F.MISC[16] = (unsigned)u; }
        __syncthreads();
        int u = (int)F.MISC[16];
        if (u < 0) break;
        if (u < DECB) { if (tmask & 1) idx_unit<true>(F, P, u, 0, tmask >> 4); continue; }
        if (u < NU_SAMPLE) { if (tmask & 2) sb_item<true>(P, u - DECB, F.wave, 0, F.lds + F.wave * WBUF, F.lane); continue; }
        u -= NU_SAMPLE;
        const int b = u / NPB, t = u % NPB;
        if (PART == 0) { if (tmask & 4) idx_unit<false>(F, P, b, NU_PB_IDX - 1 - t, tmask >> 4); continue; }
        if (t < NU_PB_DSA) { if (tmask & 4) dsa_dense_unit(F, P, b, SEQ / 64 - 1 - (t >> 1), t & 1); continue; }
        if (tmask & 8) sb_item<false>(P, b, F.wave, SEQ / 32 - 1 - (t - NU_PB_DSA), F.lds + F.wave * WBUF, F.lane);
    }
}
__device__ __forceinline__ void p7_final(const Frame& F, const Params& P) {
    const float* SS = (const float*)(P.ws + WS_SS3);
    const int gw = F.bx * NWAVES + F.wave, NGW = F.G * NWAVES;
    for (int m = gw; m < MR; m += NGW) {
        const float rs = rstd_from_parts(SS, m);
        f32x4* yr = (f32x4*)(P.out + (m < MP ? O_Y_P + (size_t)m * DM : O_Y_S + (size_t)(m - MP) * DM)) + F.lane;
        const f32x4* gf = (const f32x4*)P.g_final + F.lane;
#pragma unroll
        for (int j = 0; j < 4; ++j) { const f32x4 v = yr[64 * j], g = gf[64 * j]; yr[64 * j] = (f32x4){v[0] * rs * g[0], v[1] * rs * g[1], v[2] * rs * g[2], v[3] * rs * g[3]}; }
    }
}

constexpr int N_PHASES = 9;
__global__ void __launch_bounds__(NWAVES * 64, 2) fwd(Params P) {
    extern __shared__ __attribute__((aligned(16))) unsigned char lds_raw[];
    Frame F;
    F.lds = (LAS unsigned char*)lds_raw;
    F.MISC = (volatile LAS unsigned*)(F.lds + MISC_OFF);
    F.tid = threadIdx.x; F.lane = F.tid & 63; F.wave = __builtin_amdgcn_readfirstlane(F.tid >> 6);
    F.G = gridDim.x; F.bx = blockIdx.x;
    F.ctl = (unsigned*)(P.ws + WS_CTL);
    if (F.tid < 64) F.MISC[F.tid] = 0u;
    __syncthreads();
    const bool multi = (P.ph_hi - P.ph_lo) > 1;
    XcdBarrier bar; bar.bar = F.ctl + CW_BAR; bar.x = 0; bar.st = nullptr;
    if (multi) bar = xcd_barrier_post(F.ctl + CW_BAR, F.MISC + 8);
    unsigned char* ws = P.ws;
    const int lo = P.ph_lo, hi = P.ph_hi;
#ifndef PHMASK
#define PHMASK 0x1FF
#endif
#define IN(k) (((PHMASK >> (k)) & 1) && lo <= (k) && (k) < hi)
#define SEAM(k) do { if (IN(k) && IN((k) + 1)) xcd_barrier(bar); } while (0)

    if (IN(0)) { p0_prologue(F, P);
#ifdef PROBE_P0X2
        p0_prologue(F, P);
#endif
        SEAM(0); }
    if (IN(1)) {
        pg8::Gemm g{(const f16*)(ws + WS_XH), (const f16*)(ws + WS_WIN), DM, DM, DM}; pg8::StaticOrder S; S.init(MP, NIN, F.G, F.bx);
        EpiInProj E{(const float*)(ws + WS_RSTD1), (const f32x2*)(ws + WS_ROPE), P.out, ws};
        small_gemm_wg(F.lds, g, E, F.bx, F.G, (NIN / 256) * 32, 1, F.wave, F.lane);
        pg8::gemm_phase<EpiInProj, pg8::StaticOrder, true>(F.lds, g, S, E);
#if defined(PROBE_GX2) && ((PROBE_GX2 >> 1) & 1)
        __syncthreads(); pg8::gemm_phase<EpiInProj, pg8::StaticOrder, true>(F.lds, g, S, E);
#endif
        SEAM(1);
    }
    if (IN(2)) { p2_attention<0>(F, P, CW_QUEUE);
#ifdef PROBE_P2A
        p2_attention<0>(F, P, CW_QUEUE + 64 * 16, PROBE_P2A);
#endif
        SEAM(2); }
    if (IN(3)) { p2_attention<1>(F, P, CW_QUEUE + 64 * 8);
#ifdef PROBE_P2B
        p2_attention<1>(F, P, CW_QUEUE + 64 * 24, PROBE_P2B);
#endif
        SEAM(3); }
    if (IN(4)) {
        pg8::Gemm g{(const f16*)(ws + WS_OAB), (const f16*)(ws + WS_WBR), DM, DM, 512}; pg8::PairOrder S; S.S.init(MP, DM, F.G, F.bx); S.K = 512;
        EpiBranch E{(const f16*)(ws + WS_G), (f16*)(ws + WS_MG)};
        small_gemm_wg(F.lds, g, E, F.bx, F.G, (DM / 256) * 32, 2, F.wave, F.lane);
        pg8::gemm_phase<EpiBranch, pg8::PairOrder, false>(F.lds, g, S, E);
#if defined(PROBE_GX2) && ((PROBE_GX2 >> 4) & 1)
        __syncthreads(); pg8::gemm_phase<EpiBranch, pg8::PairOrder, false>(F.lds, g, S, E);
#endif
        SEAM(4);
    }
    if (IN(5)) {
        pg8::Gemm g{(const f16*)(ws + WS_MG), (const f16*)(ws + WS_WO), DM, DM, DM}; pg8::StaticOrder S; S.init(MP, DM, F.G, F.bx);
        EpiWo E{P.x_p, P.x_s, (float*)(ws + WS_H), (f16*)(ws + WS_HH), (float*)(ws + WS_SS2)};
        small_gemm_wg(F.lds, g, E, F.bx, F.G, (DM / 256) * 32, 1, F.wave, F.lane);
        pg8::gemm_phase<EpiWo, pg8::StaticOrder, false>(F.lds, g, S, E);
#if defined(PROBE_GX2) && ((PROBE_GX2 >> 5) & 1)
        __syncthreads(); pg8::gemm_phase<EpiWo, pg8::StaticOrder, false>(F.lds, g, S, E);
#endif
        SEAM(5);
    }
    if (IN(6)) {
        pg8::Gemm g{(const f16*)(ws + WS_HH), (const f16*)(ws + WS_WGU), DM, DM, DM}; pg8::StaticOrder S; S.init(MP, NGU, F.G, F.bx);
        EpiGateUp E{(const float*)(ws + WS_SS2), (f16*)(ws + WS_ACT)};
        if (F.bx >= F.G / 2) small_gemm_wg(F.lds, g, E, F.bx - F.G / 2, F.G - F.G / 2, (NGU / 256) * 32, 1, F.wave, F.lane);
        pg8::gemm_phase<EpiGateUp, pg8::StaticOrder, true>(F.lds, g, S, E);
#if defined(PROBE_GX2) && ((PROBE_GX2 >> 6) & 1)
        __syncthreads(); pg8::gemm_phase<EpiGateUp, pg8::StaticOrder, true>(F.lds, g, S, E);
#endif
        SEAM(6);
    }
    if (IN(7)) {
        pg8::Gemm g{(const f16*)(ws + WS_ACT), (const f16*)(ws + WS_WDN), DFF, DFF, DFF}; pg8::StaticOrder S; S.init(MP, DM, F.G, F.bx);
        EpiDown E{(const float*)(ws + WS_H), P.out, (float*)(ws + WS_SS3)};
        small_gemm_wg(F.lds, g, E, F.bx, F.G, (DM / 256) * 32, 1, F.wave, F.lane);
        pg8::gemm_phase<EpiDown, pg8::StaticOrder, false>(F.lds, g, S, E);
#if defined(PROBE_GX2) && ((PROBE_GX2 >> 7) & 1)
        __syncthreads(); pg8::gemm_phase<EpiDown, pg8::StaticOrder, false>(F.lds, g, S, E);
#endif
        SEAM(7);
    }
    if (IN(8)) p7_final(F, P);
#undef IN
#undef SEAM
}

#ifndef MK_N_LAUNCHES
#define MK_N_LAUNCHES 1
#endif
extern "C" void kernel_launch(void* const* d_in, const int* in_sizes, int n_in, void* d_out, int out_size, void* d_ws, size_t ws_size, hipStream_t stream) {
    static int grid = 0;
    if (grid == 0) {
        if (n_in != 16 || out_size != (int)O_END || ws_size < WS_END) { fprintf(stderr, "kernel_launch: unexpected sizes (n_in %d, out %d, ws %zu, need %zu)\n", n_in, out_size, ws_size, (size_t)WS_END); grid = -1; return; }
        int dev = 0, cus = 0, per_cu = 0;
        if (hipGetDevice(&dev) != hipSuccess || hipDeviceGetAttribute(&cus, hipDeviceAttributeMultiprocessorCount, dev) != hipSuccess) { grid = -1; return; }
        if (hipFuncSetAttribute((const void*)fwd, hipFuncAttributeMaxDynamicSharedMemorySize, LDS_BYTES) != hipSuccess) { fprintf(stderr, "kernel_launch: hipFuncSetAttribute failed\n"); grid = -1; return; }
        if (hipOccupancyMaxActiveBlocksPerMultiprocessor(&per_cu, (const void*)fwd, NWAVES * 64, LDS_BYTES) != hipSuccess || per_cu < 1) { fprintf(stderr, "kernel_launch: occupancy query says %d\n", per_cu); }
        (void)hipGetLastError();
        grid = cus;
    }
    if (grid < 0) return;
    (void)hipMemsetAsync((char*)d_ws + WS_CTL, 0, CTL_ZERO_BYTES, stream);
    Params p{};
    p.x_p = (const float*)d_in[0]; p.x_s = (const float*)d_in[1]; p.c_kva = (const float*)d_in[2]; p.c_ki = (const float*)d_in[3]; p.c_kvb = (const float*)d_in[4]; p.pt = (const int*)d_in[5];
    p.w_in = (const float*)d_in[6]; p.w_bra = (const float*)d_in[7]; p.w_brb = (const float*)d_in[8]; p.w_o = (const float*)d_in[9]; p.g_attn = (const float*)d_in[10]; p.g_ffn = (const float*)d_in[11];
    p.w_gate = (const float*)d_in[12]; p.w_up = (const float*)d_in[13]; p.w_down = (const float*)d_in[14]; p.g_final = (const float*)d_in[15];
    p.out = (float*)d_out; p.ws = (unsigned char*)d_ws;
#if MK_N_LAUNCHES == 1
    p.ph_lo = 0; p.ph_hi = N_PHASES;
    hipLaunchKernelGGL(fwd, dim3(grid), dim3(NWAVES * 64), LDS_BYTES, stream, p);
#else
    for (int k = 0; k < N_PHASES; ++k) { p.ph_lo = k; p.ph_hi = k + 1; hipLaunchKernelGGL(fwd, dim3(grid), dim3(NWAVES * 64), LDS_BYTES, stream, p); }
#endif
}
```
